# Optimizing an MI355X kernel written in HIP

```python
import math
import jax, jax.numpy as jnp
from jax import lax
import numpy as np

D_MODEL = 2048
BATCH = 1
SEQ = 8192
DEPTH = 4
DEC_BATCH = 32
DEC_SEQ = 16
PAST_LEN = 1024

CHUNK = 64
N_A_LAYERS = DEPTH // 2
N_B_LAYERS = DEPTH - N_A_LAYERS
POOL_WINDOWS = (2, 4, 8, 16)
N_POOL_GROUPS = len(POOL_WINDOWS)
POOL_GROUP = D_MODEL // N_POOL_GROUPS
POOL_HIST = max(POOL_WINDOWS) - 1
N_HEADS = 16
QK_DIM = 64
V_DIM = 2 * QK_DIM
Q_WIDTH = N_HEADS * 2 * QK_DIM
K_WIDTH = N_HEADS * 2 * QK_DIM
V_WIDTH = N_HEADS * V_DIM
D_FF = 5632
CONV_W = 3
Q_BLOCK = 128
LN_EPS = 1e-5
ALPHA = (2 * DEPTH) ** 0.25
BETA = (8 * DEPTH) ** -0.25
ATTN_SCALE = QK_DIM ** -0.5
NEG_INF = -1e30

kernel_name = 'yoco_pool_diffattn_streaming_step'


def layer_norm(x, g, b):
    xf = x.astype(jnp.float32)
    mu = jnp.mean(xf, axis=-1, keepdims=True)
    xc = xf - mu
    var = jnp.mean(xc * xc, axis=-1, keepdims=True)
    return (xc * lax.rsqrt(var + LN_EPS) * g + b).astype(x.dtype)


def pool_mix(u_ext, pos0, w_pool, scale):
    B, Lx, D = u_ext.shape
    L = Lx - POOL_HIST
    uf = u_ext.astype(jnp.float32)
    cs = jnp.concatenate([jnp.zeros((B, 1, D), jnp.float32), jnp.cumsum(uf, axis=1)], axis=1)
    end = cs[:, POOL_HIST + 1:]
    cur = uf[:, POOL_HIST:]
    pos = pos0 + jnp.arange(L)
    groups = []
    for g, w in enumerate(POOL_WINDOWS):
        sl = slice(g * POOL_GROUP, (g + 1) * POOL_GROUP)
        start = cs[:, POOL_HIST + 1 - w:POOL_HIST + 1 - w + L, sl]
        cnt = jnp.minimum(w, pos + 1).astype(jnp.float32)[None, :, None]
        groups.append((end[..., sl] - start) / cnt - cur[..., sl])
    d = jnp.stack(groups, axis=2)
    out = jnp.einsum('blgc,gcd->blgd', d.astype(w_pool.dtype), w_pool).reshape(B, L, D)
    return (out * scale).astype(u_ext.dtype)


def conv_ffn(x, hist, w_up, conv_w, conv_b, w_down):
    L = x.shape[1]
    h = jnp.einsum('bld,df->blf', x, w_up)
    h_ext = jnp.concatenate([hist.astype(h.dtype), h], axis=1)
    c = conv_b
    for j in range(CONV_W):
        c = c + conv_w[j] * h_ext[:, j:j + L]
    a, v = jnp.split(c, 2, axis=-1)
    y = jnp.einsum('blf,fd->bld', jax.nn.gelu(a) * v, w_down)
    return y.astype(x.dtype), h_ext[:, -(CONV_W - 1):]


def diff_lambda(lam, lam_init):
    lf = lam.astype(jnp.float32)
    return jnp.exp(jnp.sum(lf[0] * lf[1])) - jnp.exp(jnp.sum(lf[2] * lf[3])) + lam_init


def diff_combine(s, v, lam, mask):
    if mask is not None:
        s = jnp.where(mask, s, NEG_INF)
    p = jax.nn.softmax(s, axis=-1)
    w = p[:, :, 0] - lam * p[:, :, 1]
    return jnp.einsum('bhqk,bkhe->bqhe', w.astype(v.dtype), v)


def attn_prompt(q, k, v, lam):
    B, T = q.shape[:2]
    nb = T // Q_BLOCK
    qb = q.reshape(B, nb, Q_BLOCK, N_HEADS, 2, QK_DIM).transpose(1, 0, 2, 3, 4, 5)
    key_chunk = jnp.arange(T) // CHUNK

    def one(args):
        q_blk, i = args
        s = jnp.einsum('bqhid,bkhid->bhiqk', q_blk, k, preferred_element_type=jnp.float32) * ATTN_SCALE
        q_chunk = (i * Q_BLOCK + jnp.arange(Q_BLOCK)) // CHUNK
        mask = key_chunk[None, :] <= q_chunk[:, None]
        return diff_combine(s, v, lam, mask)

    o = lax.map(one, (qb, jnp.arange(nb)))
    return o.transpose(1, 0, 2, 3, 4).reshape(B, T, N_HEADS, V_DIM)


def attn_sample(q, k, v, lam):
    s = jnp.einsum('bqhid,bkhid->bhiqk', q, k, preferred_element_type=jnp.float32) * ATTN_SCALE
    return diff_combine(s, v, lam, None)


def diff_out(o, subln_g, lam_init, w_o):
    of = o.astype(jnp.float32)
    of = of * lax.rsqrt(jnp.mean(of * of, axis=-1, keepdims=True) + LN_EPS) * subln_g * (1.0 - lam_init)
    return jnp.einsum('blhe,hed->bld', of.astype(o.dtype), w_o.reshape(N_HEADS, V_DIM, D_MODEL))


def run_group(x, pool_hist, conv_hist, past_k, past_v, pos0, p):
    B, L, _ = x.shape
    new_pool, new_conv = [], []
    k_new = v_new = k_att = v_att = None
    for l in range(DEPTH):
        if l < N_A_LAYERS:
            u_ext = jnp.concatenate([pool_hist[l].astype(x.dtype), x], axis=1)
            mix = pool_mix(u_ext, pos0, p['w_pool'][l], p['pool_scale'][l])
            new_pool.append(u_ext[:, -POOL_HIST:])
        else:
            j = l - N_A_LAYERS
            lam_init = 0.8 - 0.6 * math.exp(-0.3 * l)
            lam = diff_lambda(p['lam'][j], lam_init)
            q = jnp.einsum('bld,dq->blq', x, p['w_q'][j]).reshape(B, L, N_HEADS, 2, QK_DIM)
            if past_k is None:
                o = attn_prompt(q, k_att, v_att, lam)
            else:
                o = attn_sample(q, k_att, v_att, lam)
            mix = diff_out(o, p['subln_g'][j], lam_init, p['w_o'][j]).astype(x.dtype)
        x = layer_norm(ALPHA * x + mix, p['ln1_g'][l], p['ln1_b'][l])
        f, hc = conv_ffn(x, conv_hist[l], p['w_up'][l], p['conv_w'][l], p['conv_b'][l], p['w_down'][l])
        new_conv.append(hc)
        x = layer_norm(ALPHA * x + f, p['ln2_g'][l], p['ln2_b'][l])
        if l == N_A_LAYERS - 1:
            kv = jnp.einsum('bld,dk->blk', x, p['w_kv'])
            k_new = kv[..., :K_WIDTH].reshape(B, L, N_HEADS, 2 * QK_DIM)
            v_new = kv[..., K_WIDTH:].reshape(B, L, N_HEADS, V_DIM)
            if past_k is None:
                k_all, v_all = k_new, v_new
            else:
                k_all = jnp.concatenate([past_k.astype(k_new.dtype), k_new], axis=1)
                v_all = jnp.concatenate([past_v.astype(v_new.dtype), v_new], axis=1)
            k_att = k_all.reshape(B, k_all.shape[1], N_HEADS, 2, QK_DIM)
            v_att = v_all
    return x, jnp.stack(new_pool), jnp.stack(new_conv), k_new, v_new


def setup_inputs(seed: int = 0) -> dict:
    key = jax.random.key(seed)
    ks = jax.random.split(key, 24)
    f32 = jnp.float32

    def nrm(k, shape, s):
        return jax.random.normal(k, shape, f32) * s

    w_k = nrm(ks[16], (D_MODEL, K_WIDTH), D_MODEL ** -0.5)
    w_v = nrm(ks[17], (D_MODEL, V_WIDTH), D_MODEL ** -0.5 * BETA)
    return {
        'x_prompt': nrm(ks[0], (BATCH, SEQ, D_MODEL), 1.0),
        'x_sample': nrm(ks[1], (DEC_BATCH, DEC_SEQ, D_MODEL), 1.0),
        'state_pool': nrm(ks[2], (N_A_LAYERS, DEC_BATCH, POOL_HIST, D_MODEL), 1.0),
        'state_ffn_conv': nrm(ks[3], (DEPTH, DEC_BATCH, CONV_W - 1, 2 * D_FF), BETA),
        'cache_k': nrm(ks[4], (DEC_BATCH, PAST_LEN, N_HEADS, 2 * QK_DIM), 1.0),
        'cache_v': nrm(ks[5], (DEC_BATCH, PAST_LEN, N_HEADS, V_DIM), BETA),
        'ln1_g': 1.0 + nrm(ks[6], (DEPTH, D_MODEL), 0.02),
        'ln1_b': nrm(ks[7], (DEPTH, D_MODEL), 0.02),
        'ln2_g': 1.0 + nrm(ks[8], (DEPTH, D_MODEL), 0.02),
        'ln2_b': nrm(ks[9], (DEPTH, D_MODEL), 0.02),
        'w_pool': nrm(ks[10], (N_A_LAYERS, N_POOL_GROUPS, POOL_GROUP, POOL_GROUP), POOL_GROUP ** -0.5 * BETA),
        'pool_scale': 1.0 + nrm(ks[11], (N_A_LAYERS, D_MODEL), 0.02),
        'w_up': nrm(ks[12], (DEPTH, D_MODEL, 2 * D_FF), D_MODEL ** -0.5 * BETA),
        'conv_w': nrm(ks[13], (DEPTH, CONV_W, 2 * D_FF), CONV_W ** -0.5),
        'conv_b': nrm(ks[14], (DEPTH, 2 * D_FF), 0.02),
        'w_down': nrm(ks[15], (DEPTH, D_FF, D_MODEL), D_FF ** -0.5 * BETA),
        'w_kv': jnp.concatenate([w_k, w_v], axis=1),
        'w_q': nrm(ks[18], (N_B_LAYERS, D_MODEL, Q_WIDTH), D_MODEL ** -0.5),
        'lam': nrm(ks[19], (N_B_LAYERS, 4, QK_DIM), 0.1),
        'subln_g': 1.0 + nrm(ks[20], (N_B_LAYERS, V_DIM), 0.02),
        'w_o': nrm(ks[21], (N_B_LAYERS, V_WIDTH, D_MODEL), V_WIDTH ** -0.5 * BETA),
    }


def reference(x_prompt, x_sample, state_pool, state_ffn_conv, cache_k, cache_v,
              ln1_g, ln1_b, ln2_g, ln2_b, w_pool, pool_scale, w_up, conv_w, conv_b, w_down,
              w_kv, w_q, lam, subln_g, w_o):
    p = dict(ln1_g=ln1_g, ln1_b=ln1_b, ln2_g=ln2_g, ln2_b=ln2_b, w_pool=w_pool,
             pool_scale=pool_scale, w_up=w_up, conv_w=conv_w, conv_b=conv_b, w_down=w_down,
             w_kv=w_kv, w_q=w_q, lam=lam, subln_g=subln_g, w_o=w_o)
    B = x_prompt.shape[0]
    pool0 = jnp.zeros((N_A_LAYERS, B, POOL_HIST, D_MODEL), x_prompt.dtype)
    conv0 = jnp.zeros((DEPTH, B, CONV_W - 1, 2 * D_FF), x_prompt.dtype)
    y_prompt, pool_prompt, conv_prompt, k_prompt, v_prompt = run_group(
        x_prompt, pool0, conv0, None, None, 0, p)
    y_sample, pool_sample, conv_sample, k_sample, v_sample = run_group(
        x_sample, state_pool, state_ffn_conv, cache_k, cache_v, PAST_LEN, p)
    return (y_prompt, y_sample, pool_prompt, pool_sample, conv_prompt, conv_sample,
            k_prompt, v_prompt, k_sample, v_sample)
```

```cpp
#include <hip/hip_runtime.h>
#include <cstdio>
#include <cstdint>

#ifndef KMASK
#define KMASK 0xFFFF
#endif
#define KON(k) ((KMASK >> (k)) & 1)
#ifndef MK_ONE_LAUNCH
#define MK_ONE_LAUNCH 1
#endif

#define GAS __attribute__((address_space(1)))
#define LAS __attribute__((address_space(3)))
typedef unsigned short bf16_t;
typedef short bf16x8 __attribute__((ext_vector_type(8)));
typedef float f32x4 __attribute__((ext_vector_type(4)));
typedef float f32x2 __attribute__((ext_vector_type(2)));
typedef float f32x16 __attribute__((ext_vector_type(16)));
typedef unsigned u32x4 __attribute__((ext_vector_type(4)));
typedef unsigned u32x2 __attribute__((ext_vector_type(2)));
typedef short s16x4 __attribute__((ext_vector_type(4)));

constexpr int DM = 2048, SEQ = 8192, NSAMP = 512, MROWS = SEQ + NSAMP;
constexpr int DFF = 5632, NUP = 2 * DFF, NHEAD = 16, PAST = 1024, DEPTH = 4;
constexpr float LN_EPS = 1e-5f;
constexpr float ALPHA = 1.6817928305074290f;
constexpr float QSCALE = 0.125f * 1.4426950408889634f;

__device__ __forceinline__ unsigned cvt_pk_bf16(float lo, float hi) { unsigned r; asm volatile("v_cvt_pk_bf16_f32 %0, %1, %2" : "=v"(r) : "v"(lo), "v"(hi)); return r; }
__device__ __forceinline__ unsigned short f2bf(float f) { return (unsigned short)(cvt_pk_bf16(f, 0.f) & 0xffffu); }

namespace pg8 {
constexpr int BM = 256, BK = 64, HALF = 128, HTB = HALF * BK * 2, STAGE_BYTES = 8 * HTB, NXCD = 8, WGM = 8;
__host__ __device__ __forceinline__ int lds_byte(int r, int c) { const int st = (r >> 4) * 2 + (c >> 5), rr = r & 15, cc = c & 31, ob = rr * 64 + cc * 2; return st * 1024 + (ob ^ (((ob >> 9) & 1) << 5)); }
__host__ __device__ __forceinline__ void stage_rc(int b, int& R, int& C) { const int st = b / 1024, sb = b % 1024, swz = sb ^ (((sb >> 9) & 1) << 5); R = (st >> 1) * 16 + swz / 64; C = (st & 1) * 32 + (swz % 64) / 2; }
__host__ __device__ __forceinline__ int perm32(int rho) { const int n = rho >> 4, i = rho & 15; return 8 * (i >> 2) + 4 * n + (i & 3); }

struct Unit { int pm, pn; };
struct Gemm { const bf16_t* A; const bf16_t* Bt; int lda, ldb, K, nM, nN, agrp; };

struct StaticOrder {
    int nM, nN, nwg, G, c;
    __host__ __device__ void init(int nM_, int nN_, int G_, int c_) { nM = nM_; nN = nN_; nwg = nM * nN; G = G_; c = c_; }
    __host__ __device__ bool next(int i, Unit& u) const {
        const long L = (long)i * G + c; if (L >= nwg) return false;
        int wgid = (int)L; { const int q = nwg / NXCD, r = nwg % NXCD, xcd = wgid % NXCD, off = wgid / NXCD; wgid = (xcd < r ? xcd * (q + 1) : r * (q + 1) + (xcd - r) * q) + off; }
        const int nig = WGM * nN, gid = wgid / nig, fm = gid * WGM, gsz = (nM - fm) < WGM ? (nM - fm) : WGM;
        u.pm = fm + ((wgid % nig) % gsz); u.pn = (wgid % nig) / gsz; return true;
    }
};

template <class Epi, bool ALIGN_EPI>
__device__ __forceinline__ void gemm_phase(LAS unsigned char* lds, const Gemm g, const StaticOrder& S, const Epi& E, int tid_in) {
    int tid_ = tid_in; asm volatile("" : "+v"(tid_));
    const int tid = tid_, wid = __builtin_amdgcn_readfirstlane(tid >> 6), lane = tid & 63, wr = wid >> 2, wc = wid & 3, fr = lane & 15, fq = lane >> 4;
    const int K = g.K, nt = K / BK;
    unsigned voffA[2], voffB[2];
#pragma unroll
    for (int i = 0; i < 2; ++i) { int R, C; stage_rc(tid * 16 + i * 8192, R, C); const int Rb = Epi::PERM ? ((R & ~31) + perm32(R & 31)) : R;
        voffA[i] = (unsigned)(R * g.lda + C) * 2u; voffB[i] = (unsigned)(Rb * g.ldb + C) * 2u; }
    const size_t kstep = (size_t)(BK * 2);
    const size_t hstepA = (size_t)HALF * g.lda * 2, hstepB = (size_t)HALF * g.ldb * 2;
    const size_t tstepA = 2 * hstepA, tstepB = 2 * hstepB;
    const unsigned ldsw = (unsigned)wid * 1024u;
    const int aoff = lds_byte(wr * 64 + fr, fq * 8), boff = lds_byte(wc * 32 + fr, fq * 8);
#define PG8_SA(b, h) (((b) * 2 + (h)) * HTB)
#define PG8_SB(b, h) ((4 + (b) * 2 + (h)) * HTB)
#define PG8_STAGE(bufoff, gbase, voff) do { _Pragma("unroll") for (int _i = 0; _i < 2; ++_i) \
        __builtin_amdgcn_global_load_lds((const unsigned*)((const char*)(gbase) + (voff)[_i]), (LAS unsigned*)(lds + (bufoff) + ldsw + _i * 8192), 16, 0, 0); } while (0)
#define PG8_LDA(dst, b, h) do { _Pragma("unroll") for (int m = 0; m < 4; ++m) _Pragma("unroll") for (int k = 0; k < 2; ++k) dst[m][k] = *(const LAS bf16x8*)(lds + PG8_SA(b, h) + aoff + m * 2048 + k * 1024); } while (0)
#define PG8_LDB(dst, b, h) do { _Pragma("unroll") for (int n = 0; n < 2; ++n) _Pragma("unroll") for (int k = 0; k < 2; ++k) dst[n][k] = *(const LAS bf16x8*)(lds + PG8_SB(b, h) + boff + n * 2048 + k * 1024); } while (0)
#define PG8_MMA(ai, bj, At, Bt) do { __builtin_amdgcn_s_setprio(1); _Pragma("unroll") for (int m = 0; m < 4; ++m) _Pragma("unroll") for (int n = 0; n < 2; ++n) _Pragma("unroll") for (int k = 0; k < 2; ++k) \
        acc[ai][bj][m][n] = __builtin_amdgcn_mfma_f32_16x16x32_bf16(Bt[n][k], At[m][k], acc[ai][bj][m][n], 0, 0, 0); __builtin_amdgcn_s_setprio(0); } while (0)
#define PG8_WAIT_V(n) asm volatile("s_waitcnt vmcnt(" #n ")" ::: "memory")
#define PG8_WAIT_L(n) asm volatile("s_waitcnt lgkmcnt(" #n ")" ::: "memory")
#define PG8_BAR __builtin_amdgcn_s_barrier()
#define PG8_SCHED __builtin_amdgcn_sched_barrier(0)
#define PG8_ABASE(u) ((const char*)g.A + (size_t)(u).pm * tstepA + (g.agrp ? (size_t)((u).pn / g.agrp) * (size_t)K * 2 : (size_t)0))
    Unit cur, nxt; int ui = 0;
    if (!S.next(0, cur)) return;
    f32x4 acc[2][2][4][2];
#pragma unroll
    for (int a = 0; a < 2; ++a)
#pragma unroll
        for (int b = 0; b < 2; ++b)
#pragma unroll
            for (int m = 0; m < 4; ++m)
#pragma unroll
                for (int n = 0; n < 2; ++n) acc[a][b][m][n] = (f32x4){0.f, 0.f, 0.f, 0.f};
    bf16x8 At[4][2], B0[2][2], B1[2][2];
    const char* cA = PG8_ABASE(cur); const char* cB = (const char*)g.Bt + (size_t)cur.pn * tstepB;
    PG8_STAGE(PG8_SB(0, 0), cB, voffB); PG8_STAGE(PG8_SB(0, 1), cB + hstepB, voffB); PG8_STAGE(PG8_SA(0, 0), cA, voffA); PG8_STAGE(PG8_SA(0, 1), cA + hstepA, voffA);
    if (wr == 1) PG8_BAR;
    PG8_WAIT_V(2); PG8_BAR;
    PG8_STAGE(PG8_SB(1, 0), cB + kstep, voffB); PG8_STAGE(PG8_SA(1, 0), cA + kstep, voffA); PG8_STAGE(PG8_SB(1, 1), cB + hstepB + kstep, voffB);
    PG8_WAIT_V(6); PG8_BAR;
    for (;;) {
        const bool has_next = S.next(ui + 1, nxt);
        const char* nA = has_next ? PG8_ABASE(nxt) : cA; const char* nB = has_next ? (const char*)g.Bt + (size_t)nxt.pn * tstepB : cB;
        for (int t = 0; t < nt; t += 2) {
            const bool last = (t == nt - 2);
            const char* a1 = cA + (size_t)(t + 1) * kstep;
            const char* a2 = last ? nA : cA + (size_t)(t + 2) * kstep; const char* b2 = last ? nB : cB + (size_t)(t + 2) * kstep;
            const char* a3 = a2 + kstep; const char* b3 = b2 + kstep;
            PG8_LDB(B0, 0, 0); PG8_LDB(B1, 0, 1); PG8_SCHED; PG8_LDA(At, 0, 0); PG8_STAGE(PG8_SA(1, 1), a1 + hstepA, voffA);
            PG8_WAIT_V(8); PG8_WAIT_L(0); PG8_BAR; PG8_MMA(0, 0, At, B0); PG8_MMA(0, 1, At, B1); PG8_BAR; PG8_SCHED;
            PG8_LDA(At, 0, 1); PG8_STAGE(PG8_SB(0, 0), b2, voffB); PG8_STAGE(PG8_SB(0, 1), b2 + hstepB, voffB); PG8_STAGE(PG8_SA(0, 0), a2, voffA);
            PG8_WAIT_V(8); PG8_WAIT_L(0); PG8_BAR; PG8_MMA(1, 0, At, B0); PG8_MMA(1, 1, At, B1); PG8_BAR; PG8_SCHED;
            PG8_LDB(B0, 1, 0); PG8_LDB(B1, 1, 1); PG8_SCHED; PG8_LDA(At, 1, 0); PG8_STAGE(PG8_SA(0, 1), a2 + hstepA, voffA);
            PG8_WAIT_V(8); PG8_WAIT_L(0); PG8_BAR; PG8_MMA(0, 0, At, B0); PG8_MMA(0, 1, At, B1); PG8_BAR; PG8_SCHED;
            PG8_LDA(At, 1, 1); PG8_STAGE(PG8_SB(1, 0), b3, voffB); PG8_STAGE(PG8_SB(1, 1), b3 + hstepB, voffB); PG8_STAGE(PG8_SA(1, 0), a3, voffA);
            PG8_WAIT_V(8); PG8_WAIT_L(0); PG8_BAR; PG8_MMA(1, 0, At, B0); PG8_MMA(1, 1, At, B1); PG8_BAR; PG8_SCHED;
        }
        if constexpr (ALIGN_EPI) { if (wr == 0) PG8_BAR; }
        E(acc, cur, wr, wc, fr, fq, lds);
        if (!has_next) break;
#pragma unroll
        for (int a = 0; a < 2; ++a)
#pragma unroll
            for (int b = 0; b < 2; ++b)
#pragma unroll
                for (int m = 0; m < 4; ++m)
#pragma unroll
                    for (int n = 0; n < 2; ++n) acc[a][b][m][n] = (f32x4){0.f, 0.f, 0.f, 0.f};
        cur = nxt; cA = nA; cB = nB; ++ui;
        if constexpr (ALIGN_EPI) { if (wr == 1) PG8_BAR; }
    }
    PG8_WAIT_V(0);
    if constexpr (!ALIGN_EPI) { if (wr == 0) PG8_BAR; }
    PG8_BAR;
#undef PG8_ABASE
#undef PG8_SA
#undef PG8_SB
#undef PG8_STAGE
#undef PG8_LDA
#undef PG8_LDB
#undef PG8_MMA
#undef PG8_WAIT_V
#undef PG8_WAIT_L
#undef PG8_BAR
#undef PG8_SCHED
}

struct EpiRes {
    static constexpr bool PERM = false;
    const float* xin_p; const float* xin_s;
    float* Y; const float* scale;
    __device__ __forceinline__ void operator()(const f32x4 (&acc)[2][2][4][2], const Unit& u, int wr, int wc, int fr, int fq, LAS unsigned char*) const {
        const int row0 = u.pm * BM + wr * 64 + fr, col0 = u.pn * BM + wc * 32 + 4 * fq;
        const float* xb = (u.pm < 32) ? xin_p + (size_t)row0 * DM : xin_s + (size_t)(row0 - SEQ) * DM;
        float* yb = Y + (size_t)row0 * DM;
        f32x4 sv[2][2];
#pragma unroll
        for (int bj = 0; bj < 2; ++bj)
#pragma unroll
            for (int n = 0; n < 2; ++n) sv[bj][n] = scale ? *(const f32x4*)(scale + col0 + bj * HALF + n * 16) : (f32x4){1.f, 1.f, 1.f, 1.f};
#pragma unroll
        for (int ai = 0; ai < 2; ++ai)
#pragma unroll
            for (int m = 0; m < 4; ++m) { const size_t ro = (size_t)(ai * HALF + m * 16) * DM + col0;
#pragma unroll
                for (int bj = 0; bj < 2; ++bj)
#pragma unroll
                    for (int n = 0; n < 2; ++n) { const f32x4 xv = *(const f32x4*)(xb + ro + bj * HALF + n * 16);
                        *(f32x4*)(yb + ro + bj * HALF + n * 16) = xv * ALPHA + acc[ai][bj][m][n] * sv[bj][n]; } }
    }
};
struct EpiKVQ {
    static constexpr bool PERM = true;
    float* kout_p; float* kout_s; bf16_t* Kb; int base_which;
    __device__ __forceinline__ void operator()(const f32x4 (&acc)[2][2][4][2], const Unit& u, int wr, int wc, int fr, int fq, LAS unsigned char*) const {
        const int row0 = u.pm * BM + wr * 64 + fr; int colt = u.pn * BM; const int which = base_which + colt / DM; colt -= (colt / DM) * DM;
        const int col0 = colt + wc * 32 + 8 * fq;
        bf16_t* ob = Kb + (size_t)which * ((size_t)MROWS * DM) + (size_t)row0 * DM + col0;
        float* fo = nullptr;
        if (which < 2) fo = (u.pm < 32) ? kout_p + (size_t)which * ((size_t)SEQ * DM) + (size_t)row0 * DM : kout_s + (size_t)which * ((size_t)NSAMP * DM) + (size_t)(row0 - SEQ) * DM;
        const float s = which == 2 ? QSCALE : 1.f;
#pragma unroll
        for (int ai = 0; ai < 2; ++ai)
#pragma unroll
            for (int m = 0; m < 4; ++m) { const size_t ro = (size_t)(ai * HALF + m * 16) * DM;
#pragma unroll
                for (int bj = 0; bj < 2; ++bj) { const f32x4 v0 = acc[ai][bj][m][0] * s, v1 = acc[ai][bj][m][1] * s;
                    u32x4 w; w.x = cvt_pk_bf16(v0[0], v0[1]); w.y = cvt_pk_bf16(v0[2], v0[3]); w.z = cvt_pk_bf16(v1[0], v1[1]); w.w = cvt_pk_bf16(v1[2], v1[3]);
                    *(u32x4*)(ob + ro + bj * HALF) = w;
                    if (fo) { *(f32x4*)(fo + ro + col0 + bj * HALF) = v0; *(f32x4*)(fo + ro + col0 + bj * HALF + 4) = v1; } } }
    }
};
constexpr int EXCH_OFF = 131072;
__device__ __forceinline__ float dpp_ror1(float x) { return __builtin_bit_cast(float, __builtin_amdgcn_update_dpp(0, __builtin_bit_cast(int, x), 0x121, 0xf, 0xf, false)); }
__device__ __forceinline__ float dpp_ror2(float x) { return __builtin_bit_cast(float, __builtin_amdgcn_update_dpp(0, __builtin_bit_cast(int, x), 0x122, 0xf, 0xf, false)); }
__device__ __forceinline__ float dpp_shr1(float old, float x) { return __builtin_bit_cast(float, __builtin_amdgcn_update_dpp(__builtin_bit_cast(int, old), __builtin_bit_cast(int, x), 0x111, 0xf, 0xf, false)); }
__device__ __forceinline__ float dpp_shr2(float old, float x) { return __builtin_bit_cast(float, __builtin_amdgcn_update_dpp(__builtin_bit_cast(int, old), __builtin_bit_cast(int, x), 0x112, 0xf, 0xf, false)); }
__device__ __forceinline__ float gelu_tanh(float a) {
    const float K2 = -2.3022081986f;
    const float z = a * __builtin_fmaf(a * a, K2 * 0.044715f, K2);
    return a * __builtin_amdgcn_rcpf(1.0f + __builtin_amdgcn_exp2f(z));
}
struct EpiUp {
    static constexpr bool PERM = true;
    const float* cw; const float* cb; const float* hist;
    bf16_t* G; float* hhead; float* htail;
    float* conv_p; float* conv_s;
    __device__ __forceinline__ void operator()(const f32x4 (&acc)[2][2][4][2], const Unit& u, int wr, int wc, int fr, int fq, LAS unsigned char* lds) const {
        const int f0 = u.pn * HALF + wc * 32 + 8 * fq;
        const bool sample = u.pm >= 32;
        LAS float* ex = (LAS float*)(lds + EXCH_OFF);
        const int exc = wc * 32 + 8 * fq;
        if (!sample) {
            if (fr >= 14) {
#pragma unroll
                for (int ai = 0; ai < 2; ++ai)
#pragma unroll
                    for (int bj = 0; bj < 2; ++bj)
#pragma unroll
                        for (int n = 0; n < 2; ++n) *(LAS f32x4*)(ex + ((ai * 2 + wr) * 2 + (fr - 14)) * 256 + bj * HALF + exc + 4 * n) = acc[ai][bj][3][n];
            }
            if (wr == 0 && fr < 2) {
#pragma unroll
                for (int bj = 0; bj < 2; ++bj)
#pragma unroll
                    for (int n = 0; n < 2; ++n) *(f32x4*)(hhead + (size_t)(u.pm * 2 + fr) * NUP + bj * DFF + f0 + 4 * n) = acc[0][bj][0][n];
            }
            if (wr == 1 && fr >= 14) {
#pragma unroll
                for (int bj = 0; bj < 2; ++bj)
#pragma unroll
                    for (int n = 0; n < 2; ++n) { *(f32x4*)(htail + (size_t)(u.pm * 2 + fr - 14) * NUP + bj * DFF + f0 + 4 * n) = acc[1][bj][3][n];
                        if (u.pm == 31) *(f32x4*)(conv_p + (size_t)(fr - 14) * NUP + bj * DFF + f0 + 4 * n) = acc[1][bj][3][n]; }
            }
            asm volatile("s_waitcnt lgkmcnt(0)" ::: "memory"); __builtin_amdgcn_s_barrier(); asm volatile("" ::: "memory");
        }
#pragma unroll
        for (int n = 0; n < 2; ++n) {
            __builtin_amdgcn_sched_barrier(0);
            f32x4 W0[2], W1[2], W2[2], CB[2];
#pragma unroll
            for (int bj = 0; bj < 2; ++bj) { const int col = bj * DFF + f0 + 4 * n;
                W0[bj] = *(const f32x4*)(cw + col); W1[bj] = *(const f32x4*)(cw + NUP + col); W2[bj] = *(const f32x4*)(cw + 2 * NUP + col); CB[bj] = *(const f32x4*)(cb + col); }
#pragma unroll
            for (int ai = 0; ai < 2; ++ai)
#pragma unroll
                for (int m = 0; m < 4; ++m) {
                    f32x4 pv[2];
                    const int bsm = (u.pm - 32) * 16 + ai * 8 + wr * 4 + m;
                    if (sample) {
#pragma unroll
                        for (int bj = 0; bj < 2; ++bj) { pv[bj] = (f32x4){0.f, 0.f, 0.f, 0.f};
                            if (fr >= 14) pv[bj] = *(const f32x4*)(hist + (size_t)(bsm * 2 + fr - 14) * NUP + bj * DFF + f0 + 4 * n); }
                    } else if (m > 0) {
#pragma unroll
                        for (int bj = 0; bj < 2; ++bj) pv[bj] = acc[ai][bj][m - 1][n];
                    } else {
                        const bool have = (wr == 1) || (ai == 1);
                        const int sai = (wr == 1) ? ai : 0, swr = (wr == 1) ? 0 : 1;
#pragma unroll
                        for (int bj = 0; bj < 2; ++bj) { pv[bj] = (f32x4){0.f, 0.f, 0.f, 0.f};
                            if (have && fr >= 14) pv[bj] = *(const LAS f32x4*)(ex + ((sai * 2 + swr) * 2 + (fr - 14)) * 256 + bj * HALF + exc + 4 * n); }
                    }
                    f32x4 c[2];
#pragma unroll
                    for (int bj = 0; bj < 2; ++bj)
#pragma unroll
                        for (int j = 0; j < 4; ++j) { const float h = acc[ai][bj][m][n][j], p = pv[bj][j];
                            const float hm1 = dpp_shr1(dpp_ror1(p), h), hm2 = dpp_shr2(dpp_ror2(p), h);
                            c[bj][j] = CB[bj][j] + W2[bj][j] * h + W1[bj][j] * hm1 + W0[bj][j] * hm2; }
                    const int row = u.pm * BM + ai * HALF + wr * 64 + m * 16 + fr;
                    u32x2 w; w.x = cvt_pk_bf16(gelu_tanh(c[0][0]) * c[1][0], gelu_tanh(c[0][1]) * c[1][1]); w.y = cvt_pk_bf16(gelu_tanh(c[0][2]) * c[1][2], gelu_tanh(c[0][3]) * c[1][3]);
                    const bool skip = (!sample) && u.pm > 0 && ai == 0 && wr == 0 && m == 0 && fr < 2;
                    if (!skip) *(u32x2*)(G + (size_t)row * DFF + f0 + 4 * n) = w;
                    if (sample && fr >= 14) {
#pragma unroll
                        for (int bj = 0; bj < 2; ++bj) *(f32x4*)(conv_s + (size_t)(bsm * 2 + fr - 14) * NUP + bj * DFF + f0 + 4 * n) = acc[ai][bj][m][n];
                    }
                }
        }
        if (!sample) { asm volatile("s_waitcnt lgkmcnt(0)" ::: "memory"); __builtin_amdgcn_s_barrier(); asm volatile("" ::: "memory"); }
    }
};
}

constexpr int NWAVES = 8;
constexpr size_t MiB = 1u << 20;
constexpr size_t WS_CTL = 0, CTL_ZERO_BYTES = 1 * MiB;
constexpr size_t SZ_ACT_F32 = (size_t)MROWS * DM * 4, SZ_ACT_BF = (size_t)MROWS * DM * 2;
constexpr size_t WS_WUP = 2 * MiB;
constexpr size_t WS_WDN = WS_WUP + (size_t)4 * NUP * DM * 2;
constexpr size_t WS_WKVQ = WS_WDN + (size_t)4 * DM * DFF * 2;
constexpr size_t WS_WQ3 = WS_WKVQ + (size_t)6144 * DM * 2;
constexpr size_t WS_WO = WS_WQ3 + (size_t)DM * DM * 2;
constexpr size_t WS_WPOOL = WS_WO + (size_t)2 * DM * DM * 2;
constexpr size_t WS_X = WS_WPOOL + (size_t)2 * DM * 512 * 2;
constexpr size_t WS_Y = WS_X + SZ_ACT_F32;
constexpr size_t WS_XN = WS_Y + SZ_ACT_F32;
constexpr size_t WS_DIN = WS_XN + SZ_ACT_BF;
constexpr size_t WS_G = WS_DIN + SZ_ACT_BF;
constexpr size_t WS_HH = WS_G + (size_t)MROWS * DFF * 2;
constexpr size_t WS_HT = WS_HH + (size_t)32 * 2 * NUP * 4;
constexpr size_t WS_KB = WS_HT + (size_t)32 * 2 * NUP * 4;
constexpr size_t WS_VB = WS_KB + SZ_ACT_BF, WS_QB = WS_VB + SZ_ACT_BF, WS_OB = WS_QB + SZ_ACT_BF, WS_END = WS_OB + SZ_ACT_BF;
constexpr size_t O_Y = 0, O_POOLP = 17825792, O_POOLS = 17887232, O_CONVP = 19853312, O_CONVS = 19943424, O_KP = 22827008, O_VP = 39604224, O_KS = 56381440, O_VS = 57430016;
constexpr int LDS_ML = 139264, MISC_OFF = 147456, LDS_BYTES = 147456 + 256;
constexpr int CW_BAR = 4096;

typedef GAS unsigned gu32;
#define RLX_AGENT __ATOMIC_RELAXED, __HIP_MEMORY_SCOPE_AGENT
#define LDS_WAIT() asm volatile("s_waitcnt lgkmcnt(0)" ::: "memory")
#define VM_WAIT() asm volatile("s_waitcnt vmcnt(0)" ::: "memory")

#define XB_TMO      128
#define XB_XCNT(j)  (256  + 64 * (j))
#define XB_XSUB(j)  (1280 + 64 * (j))
#define XB_XGEN(j)  (2304 + 64 * (j))
#define XB_TOP      3328
#define XB_TOPGEN   3392
#define XCD_BAR_WORDS 3456
#define XB_SPIN_CAP (1u << 18)
__device__ __forceinline__ unsigned xb_ld(unsigned* p)              { return __hip_atomic_load(p, __ATOMIC_RELAXED, __HIP_MEMORY_SCOPE_AGENT); }
__device__ __forceinline__ unsigned xb_add(unsigned* p, unsigned v) { return __hip_atomic_fetch_add(p, v, __ATOMIC_RELAXED, __HIP_MEMORY_SCOPE_AGENT); }
__device__ __forceinline__ unsigned xb_xcc_id() { return (unsigned)__builtin_amdgcn_s_getreg((3 << 11) | 20) & 0xFu; }
#define XB_SPIN(cond, bar) do { unsigned _sp = 0; while (cond) { __builtin_amdgcn_s_sleep(1); \
    if ((++_sp & 255u) == 0u) { if (xb_ld(&(bar)[XB_TMO])) break; if (_sp > XB_SPIN_CAP) { atomicAdd(&(bar)[XB_TMO], 1u); break; } } } } while (0)
struct XcdBarrier { unsigned* bar; unsigned x; volatile LAS unsigned* st; };
__device__ __forceinline__ XcdBarrier xcd_barrier_post(unsigned* bar, volatile LAS unsigned* st) {
    XcdBarrier b; b.bar = bar; b.x = xb_xcc_id(); b.st = st;
    if (threadIdx.x == 0) (void)xb_add(&bar[XB_XCNT(b.x)], 1u);
    return b;
}
__device__ __forceinline__ void xcd_barrier_complete(unsigned* bar, unsigned x, unsigned& nloc, unsigned& nx) {
    const unsigned G = gridDim.x * gridDim.y * gridDim.z;
    unsigned sum, cnt, mine, sp = 0u;
    for (;;) {
        sum = 0u; cnt = 0u; mine = 0u;
#pragma unroll
        for (unsigned j = 0; j < 16; ++j) { const unsigned c = xb_ld(&bar[XB_XCNT(j)]); sum += c; cnt += (c > 0u) ? 1u : 0u; mine = (j == x) ? c : mine; }
        if (sum == G) break;
        __builtin_amdgcn_s_sleep(1);
        if ((++sp & 255u) == 0u) { if (xb_ld(&bar[XB_TMO])) break; if (sp > XB_SPIN_CAP) { atomicAdd(&bar[XB_TMO], 1u); break; } }
    }
    nloc = mine > 0u ? mine : 1u; nx = cnt > 0u ? cnt : 1u;
}
__device__ __forceinline__ void xcd_barrier(const XcdBarrier& b, int tid_now) {
    asm volatile("s_waitcnt vmcnt(0)" ::: "memory");
    __syncthreads();
    if (tid_now == 0) {
        unsigned* bar = b.bar;
        __builtin_amdgcn_s_waitcnt(0);
        unsigned nloc = b.st[0], nx = b.st[1];
        if (nloc == 0u) { xcd_barrier_complete(bar, b.x, nloc, nx); b.st[0] = nloc; b.st[1] = nx; }
        const unsigned old = xb_add(&bar[XB_XSUB(b.x)], 1u);
        const unsigned gen = old / nloc;
        if (old + 1u == (gen + 1u) * nloc) {
            __builtin_amdgcn_fence(__ATOMIC_RELEASE, "agent");
            asm volatile("s_waitcnt vmcnt(0)" ::: "memory");
            const unsigned og = xb_add(&bar[XB_TOP], 1u);
            const unsigned tg = og / nx;
            if (og + 1u == (tg + 1u) * nx) xb_add(&bar[XB_TOPGEN], 1u);
            else XB_SPIN(xb_ld(&bar[XB_TOPGEN]) == tg, bar);
            __builtin_amdgcn_fence(__ATOMIC_ACQUIRE, "agent");
            xb_add(&bar[XB_XGEN(b.x)], 1u);
            asm volatile("s_waitcnt vmcnt(0)" ::: "memory");
        } else {
            XB_SPIN(xb_ld(&bar[XB_XGEN(b.x)]) == gen, bar);
            __builtin_amdgcn_fence(__ATOMIC_ACQUIRE, "agent");
            asm volatile("s_waitcnt vmcnt(0)" ::: "memory");
        }
    }
    __syncthreads();
}

struct Args {
    const float* in[21]; float* out; unsigned char* ws; int ph_lo, ph_hi;
};

__device__ __forceinline__ float shx(float v, int o, int lane) { return __builtin_bit_cast(float, __builtin_amdgcn_ds_bpermute((lane ^ o) << 2, __builtin_bit_cast(int, v))); }
__device__ __forceinline__ float wave_sum(float v, int lane) {
#pragma unroll
    for (int o = 1; o < 64; o <<= 1) v += shx(v, o, lane);
    return v;
}

__device__ __forceinline__ void transpose_item(const float* W, int K, int N, bf16_t* WT, int row_off, int mode, LAS float* scr, int item, int lane) {
    const int nblk = N / 32, kb = item / nblk, nb = item % nblk, k0 = 64 * kb, n0 = 32 * nb;
#pragma unroll 8
    for (int i = 0; i < 32; ++i) { const int kk = 2 * i + (lane >> 5); scr[kk * 33 + (lane & 31)] = W[(size_t)(k0 + kk) * N + n0 + (lane & 31)]; }
    LDS_WAIT(); asm volatile("" ::: "memory");
    int d0 = n0;
    if (mode == 1) d0 = (n0 < DFF) ? 256 * (n0 / 128) + (n0 % 128) : 256 * ((n0 - DFF) / 128) + 128 + ((n0 - DFF) % 128);
    const int c = lane & 7;
#pragma unroll
    for (int j = 0; j < 4; ++j) { const int n = (lane >> 3) + 8 * j; const LAS float* s = scr + (8 * c) * 33 + n;
        u32x4 o; o.x = cvt_pk_bf16(s[0 * 33], s[1 * 33]); o.y = cvt_pk_bf16(s[2 * 33], s[3 * 33]); o.z = cvt_pk_bf16(s[4 * 33], s[5 * 33]); o.w = cvt_pk_bf16(s[6 * 33], s[7 * 33]);
        *(u32x4*)(WT + (size_t)(row_off + d0 + n) * K + k0 + 8 * c) = o; }
    LDS_WAIT(); asm volatile("" ::: "memory");
}

template <int W>
__device__ __forceinline__ void pooldiff_rows2(const float* xrow0  , const float* histrow  ,
                                               int r0, bool sample, bf16_t* dout  ) {
    constexpr int WM = W - 1;
    f32x4 hbuf[WM]; f32x4 S = (f32x4){0.f, 0.f, 0.f, 0.f};
#pragma unroll
    for (int k = 0; k < WM; ++k) {
        const int t = r0 - WM + k; f32x4 v = (f32x4){0.f, 0.f, 0.f, 0.f};
        if (sample) v = *(const f32x4*)(histrow + (size_t)(15 - WM + k) * DM);
        else if (t >= 0) v = *(const f32x4*)(xrow0 + (ptrdiff_t)(k - WM) * DM);
        hbuf[k] = v; S += v;
    }
#pragma unroll
    for (int it = 0; it < 16; ++it) {
        const f32x4 x = *(const f32x4*)(xrow0 + (size_t)it * DM);
        const f32x4 T = S + x;
        const int pos = r0 + it;
        const float cnt = sample ? (float)W : (float)((pos + 1 < W) ? pos + 1 : W);
        const f32x4 d = T / cnt - x;
        u32x2 o; o.x = cvt_pk_bf16(d[0], d[1]); o.y = cvt_pk_bf16(d[2], d[3]);
        *(u32x2*)(dout + (size_t)it * DM) = o;
        S = T - hbuf[it % WM]; hbuf[it % WM] = x;
    }
}

namespace att {
__device__ __forceinline__ int crow(int r, int hi) { return (r & 3) + 8 * (r >> 2) + 4 * hi; }
__device__ __forceinline__ s16x4 vtr(const LAS char* p) { typedef short v4i16_t __attribute__((ext_vector_type(4)));
    return __builtin_bit_cast(s16x4, __builtin_amdgcn_ds_read_tr16_b64_v4i16((LAS v4i16_t*)p)); }
__device__ __forceinline__ float swapmax(float m) { auto rr = __builtin_amdgcn_permlane32_swap(__float_as_uint(m), __float_as_uint(m), false, false); return fmaxf(__uint_as_float(rr[0]), __uint_as_float(rr[1])); }
__device__ __forceinline__ float swapsum(float m) { auto rr = __builtin_amdgcn_permlane32_swap(__float_as_uint(m), __float_as_uint(m), false, false); return __uint_as_float(rr[0]) + __uint_as_float(rr[1]); }
constexpr float THR = 8.0f;
constexpr int AK = 0, AV = 32768, AWSF = 65536, AQ = 67584;

__device__ __forceinline__ void prompt_unit(int h, int qb, const bf16_t* Qb, const bf16_t* Kb, const bf16_t* Vb, bf16_t* Ob, float lam, const float* subg, float oscale, LAS unsigned char* lds, int tid_in) {
    int tid_ = tid_in; asm volatile("" : "+v"(tid_));
    const int tid = tid_, lane = tid & 63, r32 = lane & 31, hi = lane >> 5, wid = __builtin_amdgcn_readfirstlane(tid >> 6);
    const int q0 = qb * 256, NT = 4 * qb + 4, my_nt = 4 * qb + (wid >> 1) + 1;
    LAS char* qlds = (LAS char*)(lds + AQ + wid * 8192) + lane * 16;
    { const bf16_t* qrow = Qb + (size_t)(q0 + 32 * wid + r32) * DM + h * 128;
#pragma unroll
      for (int i = 0; i < 2; ++i)
#pragma unroll
          for (int d0 = 0; d0 < 4; ++d0) *(LAS bf16x8*)(qlds + (4 * i + d0) * 1024) = *(const bf16x8*)(qrow + 64 * i + 16 * d0 + 8 * hi); }
    f32x16 o1[4], o2[4];
#pragma unroll
    for (int d = 0; d < 4; ++d) { o1[d] = f32x16{}; o2[d] = f32x16{}; }
    float m1 = -1e30f, m2 = -1e30f, l1 = 0.f, l2 = 0.f;
    LAS float* wsf = (LAS float*)(lds + AWSF) + wid * 64;
    const int st0 = 2 * wid, st1 = 2 * wid + 1;
    const bf16_t* ksrc = Kb + (size_t)lane * DM + h * 128 + st0 * 8;
    const bf16_t* vsrc0 = Vb + (size_t)(16 * (st0 & 3) + (lane >> 2)) * DM + h * 128 + (st0 >> 2) * 32 + (lane & 3) * 8;
    const bf16_t* vsrc1 = Vb + (size_t)(16 * (st1 & 3) + (lane >> 2)) * DM + h * 128 + (st1 >> 2) * 32 + (lane & 3) * 8;
#define ATT_DMA(t, b) do { const size_t ro_ = (size_t)(t) * 64 * DM; \
        __builtin_amdgcn_global_load_lds((const unsigned*)(ksrc + ro_), (LAS unsigned*)(lds + AK + (b) * 16384 + st0 * 1024), 16, 0, 0); \
        __builtin_amdgcn_global_load_lds((const unsigned*)(ksrc + ro_ + 8), (LAS unsigned*)(lds + AK + (b) * 16384 + st1 * 1024), 16, 0, 0); \
        __builtin_amdgcn_global_load_lds((const unsigned*)(vsrc0 + ro_), (LAS unsigned*)(lds + AV + (b) * 16384 + st0 * 1024), 16, 0, 0); \
        __builtin_amdgcn_global_load_lds((const unsigned*)(vsrc1 + ro_), (LAS unsigned*)(lds + AV + (b) * 16384 + st1 * 1024), 16, 0, 0); } while (0)
    const int voff = ((lane >> 4) & 1) * 32 + (lane & 3) * 8 + (4 * hi + ((lane & 15) >> 2)) * 64;
    ATT_DMA(0, 0);
    for (int t = 0; t < NT; ++t) {
        const int b = t & 1;
        if (t + 1 < NT) { ATT_DMA(t + 1, b ^ 1); asm volatile("s_waitcnt vmcnt(4)" ::: "memory"); } else { asm volatile("s_waitcnt vmcnt(0)" ::: "memory"); }
        __builtin_amdgcn_s_barrier(); asm volatile("" ::: "memory");
        if (t < my_nt) {
            const LAS char* Kt = (const LAS char*)(lds + AK + b * 16384); const LAS char* Vt = (const LAS char*)(lds + AV + b * 16384);
            u32x4 pa[2][4];
#pragma unroll
            for (int i = 0; i < 2; ++i) {
                __builtin_amdgcn_sched_barrier(0);
                f32x16 p0 = f32x16{}, p1 = f32x16{};
#pragma unroll
                for (int d0 = 0; d0 < 4; ++d0) {
                    const bf16x8 qv = *(const LAS bf16x8*)(qlds + (4 * i + d0) * 1024);
                    const bf16x8 k0 = *(const LAS bf16x8*)(Kt + (8 * i + 2 * d0 + hi) * 1024 + r32 * 16);
                    const bf16x8 k1 = *(const LAS bf16x8*)(Kt + (8 * i + 2 * d0 + hi) * 1024 + 512 + r32 * 16);
                    p0 = __builtin_amdgcn_mfma_f32_32x32x16_bf16(k0, qv, p0, 0, 0, 0);
                    p1 = __builtin_amdgcn_mfma_f32_32x32x16_bf16(k1, qv, p1, 0, 0, 0);
                }
                __builtin_amdgcn_sched_barrier(0);
                float rm = fmaxf(p0[0], p1[0]);
#pragma unroll
                for (int r = 1; r < 16; ++r) rm = fmaxf(rm, fmaxf(p0[r], p1[r]));
                rm = swapmax(rm);
                float mref = i ? m2 : m1;
                if (__any(rm > mref + THR)) {
                    const float mn = fmaxf(mref, rm), alpha = __builtin_amdgcn_exp2f(mref - mn);
                    mref = mn; if (i) { m2 = mn; l2 *= alpha; } else { m1 = mn; l1 *= alpha; }
                    if (hi == 0) wsf[r32] = alpha;
                    LDS_WAIT();
#pragma unroll
                    for (int r = 0; r < 16; ++r) { const float f = wsf[crow(r, hi)];
#pragma unroll
                        for (int d = 0; d < 4; ++d) { if (i) o2[d][r] *= f; else o1[d][r] *= f; } }
                    LDS_WAIT();
                }
                float ls = 0.f;
#pragma unroll
                for (int r = 0; r < 16; ++r) { p0[r] = __builtin_amdgcn_exp2f(p0[r] - mref); p1[r] = __builtin_amdgcn_exp2f(p1[r] - mref); ls += p0[r] + p1[r]; }
                if (i) l2 += ls; else l1 += ls;
#pragma unroll
                for (int s = 0; s < 2; ++s) {
                    pa[i][s] = (u32x4){cvt_pk_bf16(p0[8 * s], p0[8 * s + 1]), cvt_pk_bf16(p0[8 * s + 2], p0[8 * s + 3]), cvt_pk_bf16(p0[8 * s + 4], p0[8 * s + 5]), cvt_pk_bf16(p0[8 * s + 6], p0[8 * s + 7])};
                    pa[i][2 + s] = (u32x4){cvt_pk_bf16(p1[8 * s], p1[8 * s + 1]), cvt_pk_bf16(p1[8 * s + 2], p1[8 * s + 3]), cvt_pk_bf16(p1[8 * s + 4], p1[8 * s + 5]), cvt_pk_bf16(p1[8 * s + 6], p1[8 * s + 7])};
                }
            }
#pragma unroll
            for (int d = 0; d < 4; ++d) {
                __builtin_amdgcn_sched_barrier(0);
                bf16x8 vf[4];
#pragma unroll
                for (int s = 0; s < 4; ++s) { const s16x4 lo = vtr(Vt + d * 4096 + s * 1024 + voff), hh = vtr(Vt + d * 4096 + s * 1024 + 512 + voff);
                    vf[s] = (bf16x8){lo[0], lo[1], lo[2], lo[3], hh[0], hh[1], hh[2], hh[3]}; }
#pragma unroll
                for (int s = 0; s < 4; ++s) {
                    o1[d] = __builtin_amdgcn_mfma_f32_32x32x16_bf16(__builtin_bit_cast(bf16x8, pa[0][s]), vf[s], o1[d], 0, 0, 0);
                    o2[d] = __builtin_amdgcn_mfma_f32_32x32x16_bf16(__builtin_bit_cast(bf16x8, pa[1][s]), vf[s], o2[d], 0, 0, 0);
                }
            }
        }
        LDS_WAIT(); __builtin_amdgcn_s_barrier(); asm volatile("" ::: "memory");
    }
#undef ATT_DMA
    l1 = swapsum(l1); l2 = swapsum(l2);
    if (hi == 0) { wsf[r32] = 1.0f / l1; wsf[32 + r32] = lam / l2; }
    LDS_WAIT();
    float gsc[4];
#pragma unroll
    for (int d = 0; d < 4; ++d) gsc[d] = subg[32 * d + r32] * oscale;
    bf16_t* ob = Ob + (size_t)(q0 + 32 * wid) * DM + h * 128 + r32;
#pragma unroll
    for (int r = 0; r < 16; ++r) {
        const int q = crow(r, hi); const float a = wsf[q], bb = wsf[32 + q];
        float v[4], ss = 0.f;
#pragma unroll
        for (int d = 0; d < 4; ++d) { v[d] = o1[d][r] * a - o2[d][r] * bb; ss += v[d] * v[d]; }
#pragma unroll
        for (int o = 1; o < 32; o <<= 1) ss += shx(ss, o, lane);
        const float rs = 1.0f / sqrtf(ss * (1.0f / 128.0f) + LN_EPS);
#pragma unroll
        for (int d = 0; d < 4; ++d) ob[(size_t)q * DM + 32 * d] = f2bf(v[d] * rs * gsc[d]);
    }
    LDS_WAIT();
}

__device__ __forceinline__ bf16x8 pack8(f32x4 a, f32x4 b) { u32x4 w; w.x = cvt_pk_bf16(a[0], a[1]); w.y = cvt_pk_bf16(a[2], a[3]); w.z = cvt_pk_bf16(b[0], b[1]); w.w = cvt_pk_bf16(b[2], b[3]); return __builtin_bit_cast(bf16x8, w); }
__device__ __forceinline__ void sample_unit(int b, int h, const bf16_t* Qb, const float* cache_k, const float* cache_v, const float* knew, const float* vnew, bf16_t* Ob,
                                            float lam, const float* subg, float oscale, LAS unsigned char* lds, int tid_in) {
    int tid_ = tid_in; asm volatile("" : "+v"(tid_));
    const int tid = tid_, lane = tid & 63, q = lane & 15, g = lane >> 4, wid = __builtin_amdgcn_readfirstlane(tid >> 6);
    bf16x8 qf[2][2];
    { const bf16_t* qrow = Qb + (size_t)(SEQ + 16 * b + q) * DM + h * 128;
#pragma unroll
      for (int i = 0; i < 2; ++i)
#pragma unroll
          for (int ks = 0; ks < 2; ++ks) qf[i][ks] = *(const bf16x8*)(qrow + 64 * i + 32 * ks + 8 * g); }
    f32x4 o[2][8];
#pragma unroll
    for (int i = 0; i < 2; ++i)
#pragma unroll
        for (int c = 0; c < 8; ++c) o[i][c] = (f32x4){0.f, 0.f, 0.f, 0.f};
    float mm[2] = {-1e30f, -1e30f}, ll[2] = {0.f, 0.f};
    const int npair = (wid == 7) ? 5 : 4;
    for (int p = 0; p < npair; ++p) {
        const float *k0, *k1, *v0, *v1; const bool dummy1 = (p >= 4);
        if (!dummy1) { const size_t kv = (size_t)128 * wid + 32 * p; const size_t off = ((size_t)(b * PAST + kv) * NHEAD + h) * 128;
            k0 = cache_k + off; k1 = k0 + (size_t)16 * DM; v0 = cache_v + off; v1 = v0 + (size_t)16 * DM; }
        else { const size_t off = (size_t)(16 * b) * DM + h * 128; k0 = knew + off; k1 = k0; v0 = vnew + off; v1 = v0; }
        bf16x8 kf[2][4];
#pragma unroll
        for (int blk = 0; blk < 2; ++blk)
#pragma unroll
            for (int ks = 0; ks < 4; ++ks) { const float* pp = (blk ? k1 : k0) + (size_t)q * DM + 32 * ks + 8 * g; kf[blk][ks] = pack8(*(const f32x4*)pp, *(const f32x4*)(pp + 4)); }
        f32x4 st[2][2];
#pragma unroll
        for (int i = 0; i < 2; ++i)
#pragma unroll
            for (int blk = 0; blk < 2; ++blk) {
                st[i][blk] = __builtin_amdgcn_mfma_f32_16x16x32_bf16(kf[blk][2 * i], qf[i][0], (f32x4){0.f, 0.f, 0.f, 0.f}, 0, 0, 0);
                st[i][blk] = __builtin_amdgcn_mfma_f32_16x16x32_bf16(kf[blk][2 * i + 1], qf[i][1], st[i][blk], 0, 0, 0);
                if (blk == 1 && dummy1) st[i][blk] = (f32x4){-1e30f, -1e30f, -1e30f, -1e30f};
            }
        bf16x8 pf[2];
#pragma unroll
        for (int i = 0; i < 2; ++i) {
            float rm = fmaxf(fmaxf(fmaxf(st[i][0][0], st[i][0][1]), fmaxf(st[i][0][2], st[i][0][3])), fmaxf(fmaxf(st[i][1][0], st[i][1][1]), fmaxf(st[i][1][2], st[i][1][3])));
            rm = fmaxf(rm, shx(rm, 16, lane)); rm = fmaxf(rm, shx(rm, 32, lane));
            if (__any(rm > mm[i] + THR)) { const float mn = fmaxf(mm[i], rm), alpha = __builtin_amdgcn_exp2f(mm[i] - mn); mm[i] = mn; ll[i] *= alpha;
#pragma unroll
                for (int c = 0; c < 8; ++c) o[i][c] *= alpha; }
            f32x4 e0, e1;
#pragma unroll
            for (int j = 0; j < 4; ++j) { e0[j] = __builtin_amdgcn_exp2f(st[i][0][j] - mm[i]); e1[j] = __builtin_amdgcn_exp2f(st[i][1][j] - mm[i]); }
            ll[i] += (e0[0] + e0[1]) + (e0[2] + e0[3]) + (e1[0] + e1[1]) + (e1[2] + e1[3]);
            pf[i] = pack8(e0, e1);
        }
#pragma unroll
        for (int dh = 0; dh < 2; ++dh) {
            f32x4 vl[8];
#pragma unroll
            for (int j = 0; j < 8; ++j) { const float* vp = (j < 4 ? v0 + (size_t)(4 * g + j) * DM : v1 + (size_t)(4 * g + j - 4) * DM) + 64 * dh + 4 * q; vl[j] = *(const f32x4*)vp; }
#pragma unroll
            for (int cc = 0; cc < 4; ++cc) {
                u32x4 w; w.x = cvt_pk_bf16(vl[0][cc], vl[1][cc]); w.y = cvt_pk_bf16(vl[2][cc], vl[3][cc]); w.z = cvt_pk_bf16(vl[4][cc], vl[5][cc]); w.w = cvt_pk_bf16(vl[6][cc], vl[7][cc]);
                const bf16x8 vf = __builtin_bit_cast(bf16x8, w);
#pragma unroll
                for (int i = 0; i < 2; ++i) o[i][4 * dh + cc] = __builtin_amdgcn_mfma_f32_16x16x32_bf16(vf, pf[i], o[i][4 * dh + cc], 0, 0, 0);
            }
        }
    }
    LAS float* ML = (LAS float*)(lds + LDS_ML);
    LAS float* slab = (LAS float*)lds;
#pragma unroll
    for (int i = 0; i < 2; ++i) { ll[i] += shx(ll[i], 16, lane); ll[i] += shx(ll[i], 32, lane);
        if (g == 0) { ML[((wid * 2 + i) * 16 + q) * 2] = mm[i]; ML[((wid * 2 + i) * 16 + q) * 2 + 1] = ll[i]; } }
    LDS_WAIT(); __builtin_amdgcn_s_barrier(); asm volatile("" ::: "memory");
#pragma unroll
    for (int i = 0; i < 2; ++i) {
        float M = -1e30f;
#pragma unroll
        for (int w = 0; w < 8; ++w) M = fmaxf(M, ML[((w * 2 + i) * 16 + q) * 2]);
        const float f = __builtin_amdgcn_exp2f(mm[i] - M);
#pragma unroll
        for (int c = 0; c < 8; ++c) *(LAS f32x4*)(slab + ((wid * 2 + i) * 16 + q) * 132 + c * 16 + 4 * g) = o[i][c] * f;
    }
    LDS_WAIT(); __builtin_amdgcn_s_barrier(); asm volatile("" ::: "memory");
    {
        const int qq = lane >> 5, ln = lane & 31, qfin = 2 * wid + qq;
        float L[2]; f32x4 s[2];
#pragma unroll
        for (int i = 0; i < 2; ++i) {
            float M = -1e30f;
#pragma unroll
            for (int w = 0; w < 8; ++w) M = fmaxf(M, ML[((w * 2 + i) * 16 + qfin) * 2]);
            float Ls = 0.f; f32x4 acc = (f32x4){0.f, 0.f, 0.f, 0.f};
#pragma unroll
            for (int w = 0; w < 8; ++w) { Ls += ML[((w * 2 + i) * 16 + qfin) * 2 + 1] * __builtin_amdgcn_exp2f(ML[((w * 2 + i) * 16 + qfin) * 2] - M);
                acc += *(const LAS f32x4*)(slab + ((w * 2 + i) * 16 + qfin) * 132 + 4 * ln); }
            L[i] = Ls; s[i] = acc;
        }
        const f32x4 of = s[0] * (1.0f / L[0]) - s[1] * (lam / L[1]);
        float ss = (of[0] * of[0] + of[1] * of[1]) + (of[2] * of[2] + of[3] * of[3]);
#pragma unroll
        for (int o2 = 1; o2 < 32; o2 <<= 1) ss += shx(ss, o2, lane);
        const float rs = oscale / sqrtf(ss * (1.0f / 128.0f) + LN_EPS);
        bf16_t* ob = Ob + (size_t)(SEQ + 16 * b + qfin) * DM + h * 128;
#pragma unroll
        for (int e = 0; e < 4; ++e) { const int d = 64 * (ln >> 4) + 4 * (4 * (ln & 3) + e) + ((ln >> 2) & 3); ob[d] = f2bf(of[e] * rs * subg[d]); }
    }
    LDS_WAIT(); __builtin_amdgcn_s_barrier(); asm volatile("" ::: "memory");
}
}

constexpr int N_PHASES = 30;
__global__ void __launch_bounds__(NWAVES * 64, 2) yoco_fwd(Args args) {
    extern __shared__ __attribute__((aligned(16))) unsigned char lds_raw[];
    LAS unsigned char* lds = (LAS unsigned char*)lds_raw;
    volatile LAS unsigned* MISC = (volatile LAS unsigned*)(lds + MISC_OFF);
    const int tid0 = threadIdx.x; const int wave0 = __builtin_amdgcn_readfirstlane(tid0 >> 6);
    const int G = gridDim.x; const int bx0 = blockIdx.x; const int vcu0 = (G % 8 == 0) ? (bx0 % 8) * (G / 8) + bx0 / 8 : bx0;
    gu32* ctl = (gu32*)(args.ws + WS_CTL);
    if (tid0 < 64) MISC[tid0] = 0u;
    __syncthreads();
    XcdBarrier bar; bar.bar = (unsigned*)ctl + CW_BAR; bar.x = 0; bar.st = nullptr;
    if (MK_ONE_LAUNCH) bar = xcd_barrier_post((unsigned*)ctl + CW_BAR, MISC + 8);
    const int lo = args.ph_lo, hi = args.ph_hi;

#define x_prompt (ap->in[0])
#define x_sample (ap->in[1])
#define state_pool (ap->in[2])
#define state_conv (ap->in[3])
#define cache_k (ap->in[4])
#define cache_v (ap->in[5])
#define ln1_g (ap->in[6])
#define ln1_b (ap->in[7])
#define ln2_g (ap->in[8])
#define ln2_b (ap->in[9])
#define w_pool (ap->in[10])
#define pool_scale (ap->in[11])
#define w_up (ap->in[12])
#define conv_w (ap->in[13])
#define conv_b (ap->in[14])
#define w_down (ap->in[15])
#define w_kv (ap->in[16])
#define w_q (ap->in[17])
#define lam_in (ap->in[18])
#define subln_g (ap->in[19])
#define w_o (ap->in[20])
#define WUP ((bf16_t*)(ws + WS_WUP))
#define WDN ((bf16_t*)(ws + WS_WDN))
#define WKVQ ((bf16_t*)(ws + WS_WKVQ))
#define WQ3 ((bf16_t*)(ws + WS_WQ3))
#define WO ((bf16_t*)(ws + WS_WO))
#define WPOOL ((bf16_t*)(ws + WS_WPOOL))
#define X ((float*)(ws + WS_X))
#define Y ((float*)(ws + WS_Y))
#define XN ((bf16_t*)(ws + WS_XN))
#define DIN ((bf16_t*)(ws + WS_DIN))
#define Gb ((bf16_t*)(ws + WS_G))
#define HH ((float*)(ws + WS_HH))
#define HT ((float*)(ws + WS_HT))
#define KB ((bf16_t*)(ws + WS_KB))
#define VB ((bf16_t*)(ws + WS_VB))
#define QB ((bf16_t*)(ws + WS_QB))
#define OB ((bf16_t*)(ws + WS_OB))
    const int NGW = G * NWAVES;
    int ph = 0;
#define PH_BEGIN if (ph >= lo && ph < hi) { const __attribute__((address_space(4))) Args* ap = (const __attribute__((address_space(4))) Args*)__builtin_amdgcn_kernarg_segment_ptr(); asm volatile("" : "+s"(ap)); unsigned char* ws = ap->ws; float* out = ap->out; int bx = bx0, vcu = vcu0; asm volatile("" : "+s"(bx), "+s"(vcu)); int tid; asm volatile("v_mbcnt_lo_u32_b32 %0, -1, 0\n\tv_mbcnt_hi_u32_b32 %0, -1, %0" : "=v"(tid)); tid += wave0 * 64; const int lane = tid & 63; const int wave = __builtin_amdgcn_readfirstlane(tid >> 6); const int gw = vcu * NWAVES + wave; (void)lane; (void)gw;
#define PH_END if (MK_ONE_LAUNCH && ph + 1 < hi) xcd_barrier(bar, tid); } ++ph;

#define POOLDIFF(l, xp, xs) do { \
        for (int un = bx; un < 544; un += G) { \
            const bool smp = un >= 512; const int r0 = smp ? (un - 512) * 16 : un * 16; const int c0 = 4 * tid; \
            const float* xr = (smp ? (xs) : (xp)) + (size_t)r0 * DM + c0; \
            const float* hr = smp ? state_pool + ((size_t)((l) * 32 + (un - 512)) * 15) * DM + c0 : nullptr; \
            bf16_t* dr = DIN + (size_t)(smp ? SEQ + r0 : r0) * DM + c0; \
            const int grp = c0 >> 9; \
            if (grp == 0) pooldiff_rows2<2>(xr, hr, r0, smp, dr); else if (grp == 1) pooldiff_rows2<4>(xr, hr, r0, smp, dr); \
            else if (grp == 2) pooldiff_rows2<8>(xr, hr, r0, smp, dr); else pooldiff_rows2<16>(xr, hr, r0, smp, dr); \
            if (smp) { float* po = out + O_POOLS + ((size_t)((l) * 32 + (un - 512)) * 15) * DM + c0; \
                for (int t = 1; t < 16; ++t) *(f32x4*)(po + (size_t)(t - 1) * DM) = *(const f32x4*)(xr + (size_t)t * DM); } \
            else if (un == 511) { float* po = out + O_POOLP + (size_t)(l) * 15 * DM + c0; \
                for (int t = 1; t < 16; ++t) *(f32x4*)(po + (size_t)(t - 1) * DM) = *(const f32x4*)(xr + (size_t)t * DM); } \
        } } while (0)
#define LNPHASE(gp, bp, xo, wr_xn) do { \
        for (int m = gw; m < MROWS; m += NGW) { \
            const f32x4* yr = (const f32x4*)(Y + (size_t)m * DM) + lane; f32x4 v[8]; float s = 0.f; \
            _Pragma("unroll") for (int j = 0; j < 8; ++j) { v[j] = yr[64 * j]; s += (v[j][0] + v[j][1]) + (v[j][2] + v[j][3]); } \
            const float mean = wave_sum(s, lane) * (1.f / DM); float s2 = 0.f; \
            _Pragma("unroll") for (int j = 0; j < 8; ++j) { v[j] = v[j] - mean; s2 += (v[j][0] * v[j][0] + v[j][1] * v[j][1]) + (v[j][2] * v[j][2] + v[j][3] * v[j][3]); } \
            const float rstd = 1.f / sqrtf(wave_sum(s2, lane) * (1.f / DM) + LN_EPS); \
            f32x4* xr = (f32x4*)((xo) + (size_t)m * DM) + lane; u32x2* nr = (u32x2*)(XN + (size_t)m * DM) + lane; \
            _Pragma("unroll") for (int j = 0; j < 8; ++j) { const f32x4 gg = ((const f32x4*)(gp))[lane + 64 * j], bb = ((const f32x4*)(bp))[lane + 64 * j]; \
                const f32x4 r = v[j] * rstd * gg + bb; xr[64 * j] = r; \
                if (wr_xn) { u32x2 o; o.x = cvt_pk_bf16(r[0], r[1]); o.y = cvt_pk_bf16(r[2], r[3]); nr[64 * j] = o; } } \
        } } while (0)

    PH_BEGIN
    if (KON(0)) {
        LAS float* scr = (LAS float*)(lds + wave * 16384);
        constexpr int I_UP = (DM / 64) * (NUP / 32), I_DN = (DFF / 64) * (DM / 32), I_KV = (DM / 64) * (4096 / 32), I_SQ = (DM / 64) * (DM / 32), I_PL = (512 / 64) * (512 / 32);
        constexpr int NITEMS = 4 * I_UP + 4 * I_DN + I_KV + 2 * I_SQ + 2 * I_SQ + 8 * I_PL;
        for (int it = gw; it < NITEMS; it += NGW) {
            int r = it;
            if (r < 4 * I_UP) { const int l = r / I_UP; transpose_item(w_up + (size_t)l * DM * NUP, DM, NUP, WUP + (size_t)l * NUP * DM, 0, 1, scr, r % I_UP, lane); continue; } r -= 4 * I_UP;
            if (r < 4 * I_DN) { const int l = r / I_DN; transpose_item(w_down + (size_t)l * DFF * DM, DFF, DM, WDN + (size_t)l * DM * DFF, 0, 0, scr, r % I_DN, lane); continue; } r -= 4 * I_DN;
            if (r < I_KV) { transpose_item(w_kv, DM, 4096, WKVQ, 0, 0, scr, r, lane); continue; } r -= I_KV;
            if (r < 2 * I_SQ) { const int j = r / I_SQ; transpose_item(w_q + (size_t)j * DM * DM, DM, DM, j == 0 ? WKVQ : WQ3, j == 0 ? 4096 : 0, 0, scr, r % I_SQ, lane); continue; } r -= 2 * I_SQ;
            if (r < 2 * I_SQ) { const int j = r / I_SQ; transpose_item(w_o + (size_t)j * DM * DM, DM, DM, WO + (size_t)j * DM * DM, 0, 0, scr, r % I_SQ, lane); continue; } r -= 2 * I_SQ;
            { const int lg = r / I_PL; transpose_item(w_pool + (size_t)lg * 512 * 512, 512, 512, WPOOL + (size_t)(lg / 4) * DM * 512, (lg % 4) * 512, 0, scr, r % I_PL, lane); }
        }
        if (KON(1)) POOLDIFF(0, x_prompt, x_sample);
    }
    PH_END

    for (int l = 0; l < DEPTH; ++l) {
        if (l < 2) {
            if (l == 1) {
                PH_BEGIN
                if (KON(1)) POOLDIFF(1, X, X + (size_t)SEQ * DM);
                PH_END
            }
            PH_BEGIN
            if (KON(2)) { pg8::Gemm g{DIN, WPOOL + (size_t)l * DM * 512, DM, 512, 512, 34, 8, 2}; pg8::StaticOrder S; S.init(34, 8, G, bx);
              pg8::EpiRes E{l == 0 ? x_prompt : X, l == 0 ? x_sample : X + (size_t)SEQ * DM, Y, pool_scale + (size_t)l * DM};
              pg8::gemm_phase<pg8::EpiRes, true>(lds, g, S, E, tid); }
            PH_END
        } else {
            const int j = l - 2;
            if (l == 2) {
                PH_BEGIN
                if (KON(3)) { pg8::Gemm g{XN, WKVQ, DM, DM, DM, 34, 24, 0}; pg8::StaticOrder S; S.init(34, 24, G, bx);
                  pg8::EpiKVQ E{out + O_KP, out + O_KS, KB, 0};
                  pg8::gemm_phase<pg8::EpiKVQ, true>(lds, g, S, E, tid); }
                PH_END
            } else {
                PH_BEGIN
                if (KON(4)) { pg8::Gemm g{XN, WQ3, DM, DM, DM, 34, 8, 0}; pg8::StaticOrder S; S.init(34, 8, G, bx);
                  pg8::EpiKVQ E{nullptr, nullptr, KB, 2};
                  pg8::gemm_phase<pg8::EpiKVQ, true>(lds, g, S, E, tid); }
                PH_END
            }
            PH_BEGIN
            if (KON(5)) {
                const float lam_init = (l == 2) ? 0.47071301834583585f : 0.5560582041547941f;
                const float* lp = lam_in + (size_t)j * 256;
                const float s01 = wave_sum(lp[lane] * lp[64 + lane], lane), s23 = wave_sum(lp[128 + lane] * lp[192 + lane], lane);
                const float lam = expf(s01) - expf(s23) + lam_init;
                const float oscale = 1.0f - lam_init;
                const float* sg = subln_g + (size_t)j * 128;
                for (int un = vcu; un < 256; un += G) {
                    const int h = un >> 4, s = un & 15;
                    att::prompt_unit(h, s, QB, KB, VB, OB, lam, sg, oscale, lds, tid);
                    att::prompt_unit(h, 31 - s, QB, KB, VB, OB, lam, sg, oscale, lds, tid);
                }
                for (int un = vcu; un < 512; un += G) att::sample_unit(un >> 4, un & 15, QB, cache_k, cache_v, out + O_KS, out + O_VS, OB, lam, sg, oscale, lds, tid);
            }
            PH_END
            PH_BEGIN
            if (KON(6)) { pg8::Gemm g{OB, WO + (size_t)j * DM * DM, DM, DM, DM, 34, 8, 0}; pg8::StaticOrder S; S.init(34, 8, G, bx);
              pg8::EpiRes E{X, X + (size_t)SEQ * DM, Y, nullptr};
              pg8::gemm_phase<pg8::EpiRes, true>(lds, g, S, E, tid); }
            PH_END
        }
        PH_BEGIN
        if (KON(7)) LNPHASE(ln1_g + (size_t)l * DM, ln1_b + (size_t)l * DM, X, true);
        PH_END
        PH_BEGIN
        if (KON(8)) { pg8::Gemm g{XN, WUP + (size_t)l * NUP * DM, DM, DM, DM, 34, 44, 0}; pg8::StaticOrder S; S.init(34, 44, G, bx);
          pg8::EpiUp E{conv_w + (size_t)l * 3 * NUP, conv_b + (size_t)l * NUP, state_conv + (size_t)l * 32 * 2 * NUP, Gb, HH, HT, out + O_CONVP + (size_t)l * 2 * NUP, out + O_CONVS + (size_t)l * 32 * 2 * NUP};
          pg8::gemm_phase<pg8::EpiUp, true>(lds, g, S, E, tid); }
        PH_END
        PH_BEGIN
        if (KON(9)) {
            const float* cw = conv_w + (size_t)l * 3 * NUP; const float* cbp = conv_b + (size_t)l * NUP;
            for (int it = bx * 512 + tid; it < 31 * 2 * (DFF / 4); it += G * 512) {
                const int f = (it % (DFF / 4)) * 4, rr = (it / (DFF / 4)) & 1, pm = 1 + it / (2 * (DFF / 4));
                float gg[4];
                f32x4 cc[2];
#pragma unroll
                for (int bj = 0; bj < 2; ++bj) { const int col = bj * DFF + f;
                    const f32x4 hd0 = *(const f32x4*)(HH + (size_t)(pm * 2 + 0) * NUP + col), hd1 = *(const f32x4*)(HH + (size_t)(pm * 2 + 1) * NUP + col);
                    const f32x4 tl0 = *(const f32x4*)(HT + (size_t)((pm - 1) * 2 + 0) * NUP + col), tl1 = *(const f32x4*)(HT + (size_t)((pm - 1) * 2 + 1) * NUP + col);
                    const f32x4 h0 = rr ? hd1 : hd0, hm1 = rr ? hd0 : tl1, hm2 = rr ? tl1 : tl0;
                    cc[bj] = *(const f32x4*)(cbp + col) + *(const f32x4*)(cw + 2 * NUP + col) * h0 + *(const f32x4*)(cw + NUP + col) * hm1 + *(const f32x4*)(cw + col) * hm2; }
#pragma unroll
                for (int jj = 0; jj < 4; ++jj) gg[jj] = pg8::gelu_tanh(cc[0][jj]) * cc[1][jj];
                u32x2 o; o.x = cvt_pk_bf16(gg[0], gg[1]); o.y = cvt_pk_bf16(gg[2], gg[3]);
                *(u32x2*)(Gb + (size_t)(pm * 256 + rr) * DFF + f) = o;
            }
        }
        PH_END
        PH_BEGIN
        if (KON(10)) { pg8::Gemm g{Gb, WDN + (size_t)l * DM * DFF, DFF, DFF, DFF, 34, 8, 0}; pg8::StaticOrder S; S.init(34, 8, G, bx);
          pg8::EpiRes E{X, X + (size_t)SEQ * DM, Y, nullptr};
          pg8::gemm_phase<pg8::EpiRes, true>(lds, g, S, E, tid); }
        PH_END
        PH_BEGIN
        if (!KON(7)) {} else if (l == DEPTH - 1) { LNPHASE(ln2_g + (size_t)l * DM, ln2_b + (size_t)l * DM, out + O_Y, false); }
        else { LNPHASE(ln2_g + (size_t)l * DM, ln2_b + (size_t)l * DM, X, true); }
        PH_END
    }
#undef PH_BEGIN
#undef PH_END
}

extern "C" void kernel_launch(void* const* d_in, const int* in_sizes, int n_in, void* d_out, int out_size, void* d_ws, size_t ws_size, hipStream_t stream) {
    static int grid = 0;
    if (grid == 0) {
        if (n_in != 21 || ws_size < WS_END) { fprintf(stderr, "kernel_launch: unexpected inputs (n_in %d, ws %zu, need %zu)\n", n_in, ws_size, (size_t)WS_END); grid = -1; return; }
        int dev = 0, cus = 0, per_cu = 0;
        if (hipGetDevice(&dev) != hipSuccess || hipDeviceGetAttribute(&cus, hipDeviceAttributeMultiprocessorCount, dev) != hipSuccess) { grid = -1; return; }
        if (hipFuncSetAttribute((const void*)yoco_fwd, hipFuncAttributeMaxDynamicSharedMemorySize, LDS_BYTES) != hipSuccess) { fprintf(stderr, "kernel_launch: hipFuncSetAttribute failed\n"); grid = -1; return; }
        if (hipOccupancyMaxActiveBlocksPerMultiprocessor(&per_cu, (const void*)yoco_fwd, NWAVES * 64, LDS_BYTES) != hipSuccess || per_cu < 1)
            fprintf(stderr, "kernel_launch: occupancy query reports %d workgroups per CU\n", per_cu);
        (void)hipGetLastError();
        grid = cus;
    }
    if (grid < 0) return;
    (void)hipMemsetAsync((char*)d_ws + WS_CTL, 0, CTL_ZERO_BYTES, stream);
    Args a{};
    for (int i = 0; i < 21; ++i) a.in[i] = (const float*)d_in[i];
    a.out = (float*)d_out; a.ws = (unsigned char*)d_ws;
#if MK_ONE_LAUNCH
    a.ph_lo = 0; a.ph_hi = N_PHASES;
    hipLaunchKernelGGL(yoco_fwd, dim3(grid), dim3(NWAVES * 64), LDS_BYTES, stream, a);
#else
    for (int p = 0; p < N_PHASES; ++p) { a.ph_lo = p; a.ph_hi = p + 1; hipLaunchKernelGGL(yoco_fwd, dim3(grid), dim3(NWAVES * 64), LDS_BYTES, stream, a); }
#endif
}
```

```cpp
#include <hip/hip_runtime.h>
#include <cstdio>
#include <cstdint>

#ifndef KMASK
#define KMASK 0xFFFF
#endif
#define KON(k) ((KMASK >> (k)) & 1)
#ifndef REPMASK
#define REPMASK 0
#endif
#define KREP(k) for (int rep_ = 0; rep_ < 1 + ((REPMASK >> (k)) & 1); ++rep_)
#ifndef MK_ONE_LAUNCH
#define MK_ONE_LAUNCH 1
#endif

#define GAS __attribute__((address_space(1)))
#define LAS __attribute__((address_space(3)))
typedef unsigned short bf16_t;
typedef short bf16x8 __attribute__((ext_vector_type(8)));
typedef float f32x4 __attribute__((ext_vector_type(4)));
typedef float f32x2 __attribute__((ext_vector_type(2)));
typedef float f32x16 __attribute__((ext_vector_type(16)));
typedef unsigned u32x4 __attribute__((ext_vector_type(4)));
typedef unsigned u32x2 __attribute__((ext_vector_type(2)));
typedef short s16x4 __attribute__((ext_vector_type(4)));

constexpr int DM = 2048, SEQ = 8192, NSAMP = 512, MROWS = SEQ + NSAMP;
constexpr int DFF = 5632, NUP = 2 * DFF, NHEAD = 16, PAST = 1024, DEPTH = 4;
constexpr float LN_EPS = 1e-5f;
constexpr float ALPHA = 1.6817928305074290f;
constexpr float QSCALE = 0.125f * 1.4426950408889634f;

__device__ __forceinline__ unsigned cvt_pk_bf16(float lo, float hi) { unsigned r; asm volatile("v_cvt_pk_bf16_f32 %0, %1, %2" : "=v"(r) : "v"(lo), "v"(hi)); return r; }
__device__ __forceinline__ unsigned short f2bf(float f) { return (unsigned short)(cvt_pk_bf16(f, 0.f) & 0xffffu); }

namespace pg8 {
constexpr int BM = 256, BK = 64, HALF = 128, HTB = HALF * BK * 2, STAGE_BYTES = 8 * HTB, NXCD = 8, WGM = 8;
__host__ __device__ __forceinline__ int lds_byte(int r, int c) { const int st = (r >> 4) * 2 + (c >> 5), rr = r & 15, cc = c & 31, ob = rr * 64 + cc * 2; return st * 1024 + (ob ^ (((ob >> 9) & 1) << 5)); }
__host__ __device__ __forceinline__ void stage_rc(int b, int& R, int& C) { const int st = b / 1024, sb = b % 1024, swz = sb ^ (((sb >> 9) & 1) << 5); R = (st >> 1) * 16 + swz / 64; C = (st & 1) * 32 + (swz % 64) / 2; }
__host__ __device__ __forceinline__ int perm32(int rho) { const int n = rho >> 4, i = rho & 15; return 8 * (i >> 2) + 4 * n + (i & 3); }

struct Unit { int pm, pn, k0, nt, kc; };
struct Gemm { const bf16_t* A; const bf16_t* Bt; int lda, ldb, K, agrp; };

struct StaticOrder {
    int nN, nS, ksplit, ntS, ntP, nwg, G, c;
    __host__ __device__ void init(int nN_, int ntK, int ksplit_, int G_, int c_) { nN = nN_; ksplit = ksplit_; nS = 2 * nN_ * ksplit_; ntS = ntK / ksplit_; ntP = ntK; nwg = 32 * nN_; G = G_; c = c_; }
    __host__ __device__ bool next(int i, Unit& u) const {
        const long L = (long)i * G + c; if (L >= nS + nwg) return false;
        if (L < nS) { const int sub = (int)L, kc = sub % ksplit, t = sub / ksplit; u.pn = t % nN; u.pm = 32 + t / nN; u.k0 = kc * ntS; u.nt = ntS; u.kc = ksplit > 1 ? kc : -1; return true; }
        int wgid = (int)(L - nS); { const int q = nwg / NXCD, xcd = wgid % NXCD, off = wgid / NXCD; wgid = xcd * q + off; }
        const int nig = WGM * nN, gid = wgid / nig, fm = gid * WGM;
        u.pm = fm + ((wgid % nig) % WGM); u.pn = (wgid % nig) / WGM; u.k0 = 0; u.nt = ntP; u.kc = -1; return true;
    }
};

template <class Epi, bool ALIGN_EPI>
__device__ __forceinline__ void gemm_phase(LAS unsigned char* lds, const Gemm g, const StaticOrder& S, const Epi& E, int tid_in) {
    int tid_ = tid_in; asm volatile("" : "+v"(tid_));
    const int tid = tid_, wid = __builtin_amdgcn_readfirstlane(tid >> 6), lane = tid & 63, wr = wid >> 2, wc = wid & 3, fr = lane & 15, fq = lane >> 4;
    const int K = g.K;
    unsigned voffA[2], voffB[2];
#pragma unroll
    for (int i = 0; i < 2; ++i) { int R, C; stage_rc(tid * 16 + i * 8192, R, C); const int Rb = Epi::PERM ? ((R & ~31) + perm32(R & 31)) : R;
        const int Ra = 128 * (R >> 6) + (R & 63);
        voffA[i] = (unsigned)(Ra * g.lda + C) * 2u; voffB[i] = (unsigned)(Rb * g.ldb + C) * 2u; }
    const size_t kstep = (size_t)(BK * 2);
    const size_t hstepA = (size_t)64 * g.lda * 2, hstepB = (size_t)HALF * g.ldb * 2;
    const size_t tstepA = (size_t)BM * g.lda * 2, tstepB = 2 * hstepB;
    const unsigned ldsw = (unsigned)wid * 1024u;
    const int aoff = lds_byte(wr * 64 + fr, fq * 8), boff = lds_byte(wc * 32 + fr, fq * 8);
#define PG8_SA(b, h) (((b) * 2 + (h)) * HTB)
#define PG8_SB(b, h) ((4 + (b) * 2 + (h)) * HTB)
#define PG8_STAGE(bufoff, gbase, voff) do { _Pragma("unroll") for (int _i = 0; _i < 2; ++_i) \
        __builtin_amdgcn_global_load_lds((const unsigned*)((const char*)(gbase) + (voff)[_i]), (LAS unsigned*)(lds + (bufoff) + ldsw + _i * 8192), 16, 0, 0); } while (0)
#define PG8_LDA(dst, b, h) do { _Pragma("unroll") for (int m = 0; m < 4; ++m) _Pragma("unroll") for (int k = 0; k < 2; ++k) dst[m][k] = *(const LAS bf16x8*)(lds + PG8_SA(b, h) + aoff + m * 2048 + k * 1024); } while (0)
#define PG8_LDB(dst, b, h) do { _Pragma("unroll") for (int n = 0; n < 2; ++n) _Pragma("unroll") for (int k = 0; k < 2; ++k) dst[n][k] = *(const LAS bf16x8*)(lds + PG8_SB(b, h) + boff + n * 2048 + k * 1024); } while (0)
#define PG8_MMA(ai, bj, At, Bt) do { __builtin_amdgcn_s_setprio(1); _Pragma("unroll") for (int m = 0; m < 4; ++m) _Pragma("unroll") for (int n = 0; n < 2; ++n) _Pragma("unroll") for (int k = 0; k < 2; ++k) \
        acc[ai][bj][m][n] = __builtin_amdgcn_mfma_f32_16x16x32_bf16(Bt[n][k], At[m][k], acc[ai][bj][m][n], 0, 0, 0); __builtin_amdgcn_s_setprio(0); } while (0)
#define PG8_WAIT_V(n) asm volatile("s_waitcnt vmcnt(" #n ")" ::: "memory")
#define PG8_WAIT_L(n) asm volatile("s_waitcnt lgkmcnt(" #n ")" ::: "memory")
#define PG8_BAR __builtin_amdgcn_s_barrier()
#define PG8_SCHED __builtin_amdgcn_sched_barrier(0)
#define PG8_ABASE(u) ((const char*)g.A + (size_t)(u).pm * tstepA + (size_t)(u).k0 * kstep + (g.agrp ? (size_t)((u).pn / g.agrp) * (size_t)K * 2 : (size_t)0))
#define PG8_BBASE(u) ((const char*)g.Bt + (size_t)(u).pn * tstepB + (size_t)(u).k0 * kstep)
    Unit cur, nxt; int ui = 0;
    if (!S.next(0, cur)) return;
    f32x4 acc[2][2][4][2];
#pragma unroll
    for (int a = 0; a < 2; ++a)
#pragma unroll
        for (int b = 0; b < 2; ++b)
#pragma unroll
            for (int m = 0; m < 4; ++m)
#pragma unroll
                for (int n = 0; n < 2; ++n) acc[a][b][m][n] = (f32x4){0.f, 0.f, 0.f, 0.f};
    bf16x8 At[4][2], B0[2][2], B1[2][2];
    const char* cA = PG8_ABASE(cur); const char* cB = PG8_BBASE(cur);
    PG8_STAGE(PG8_SB(0, 0), cB, voffB); PG8_STAGE(PG8_SB(0, 1), cB + hstepB, voffB); PG8_STAGE(PG8_SA(0, 0), cA, voffA); PG8_STAGE(PG8_SA(0, 1), cA + hstepA, voffA);
    if (wr == 1) PG8_BAR;
    PG8_WAIT_V(2); PG8_BAR;
    PG8_STAGE(PG8_SB(1, 0), cB + kstep, voffB); PG8_STAGE(PG8_SA(1, 0), cA + kstep, voffA); PG8_STAGE(PG8_SB(1, 1), cB + hstepB + kstep, voffB);
    PG8_WAIT_V(6); PG8_BAR;
    for (;;) {
        const bool has_next = S.next(ui + 1, nxt);
        const char* nA = has_next ? PG8_ABASE(nxt) : cA; const char* nB = has_next ? PG8_BBASE(nxt) : cB;
        const int nt = cur.nt;
        for (int t = 0; t < nt; t += 2) {
            const bool last = (t == nt - 2);
            const char* a1 = cA + (size_t)(t + 1) * kstep;
            const char* a2 = last ? nA : cA + (size_t)(t + 2) * kstep; const char* b2 = last ? nB : cB + (size_t)(t + 2) * kstep;
            const char* a3 = a2 + kstep; const char* b3 = b2 + kstep;
            PG8_LDB(B0, 0, 0); PG8_LDB(B1, 0, 1); PG8_SCHED; PG8_LDA(At, 0, 0); PG8_STAGE(PG8_SA(1, 1), a1 + hstepA, voffA);
            PG8_WAIT_V(8); PG8_WAIT_L(0); PG8_BAR; PG8_MMA(0, 0, At, B0); PG8_MMA(0, 1, At, B1); PG8_BAR; PG8_SCHED;
            PG8_LDA(At, 0, 1); PG8_STAGE(PG8_SB(0, 0), b2, voffB); PG8_STAGE(PG8_SB(0, 1), b2 + hstepB, voffB); PG8_STAGE(PG8_SA(0, 0), a2, voffA);
            PG8_WAIT_V(8); PG8_WAIT_L(0); PG8_BAR; PG8_MMA(1, 0, At, B0); PG8_MMA(1, 1, At, B1); PG8_BAR; PG8_SCHED;
            PG8_LDB(B0, 1, 0); PG8_LDB(B1, 1, 1); PG8_SCHED; PG8_LDA(At, 1, 0); PG8_STAGE(PG8_SA(0, 1), a2 + hstepA, voffA);
            PG8_WAIT_V(8); PG8_WAIT_L(0); PG8_BAR; PG8_MMA(0, 0, At, B0); PG8_MMA(0, 1, At, B1); PG8_BAR; PG8_SCHED;
            PG8_LDA(At, 1, 1); PG8_STAGE(PG8_SB(1, 0), b3, voffB); PG8_STAGE(PG8_SB(1, 1), b3 + hstepB, voffB); PG8_STAGE(PG8_SA(1, 0), a3, voffA);
            PG8_WAIT_V(8); PG8_WAIT_L(0); PG8_BAR; PG8_MMA(1, 0, At, B0); PG8_MMA(1, 1, At, B1); PG8_BAR; PG8_SCHED;
        }
        if constexpr (ALIGN_EPI) { if (wr == 0) PG8_BAR; }
        E(acc, cur, wr, wc, fr, fq, lds);
        if (!has_next) break;
#pragma unroll
        for (int a = 0; a < 2; ++a)
#pragma unroll
            for (int b = 0; b < 2; ++b)
#pragma unroll
                for (int m = 0; m < 4; ++m)
#pragma unroll
                    for (int n = 0; n < 2; ++n) acc[a][b][m][n] = (f32x4){0.f, 0.f, 0.f, 0.f};
        cur = nxt; cA = nA; cB = nB; ++ui;
        if constexpr (ALIGN_EPI) { if (wr == 1) PG8_BAR; }
    }
    PG8_WAIT_V(0);
    if constexpr (!ALIGN_EPI) { if (wr == 0) PG8_BAR; }
    PG8_BAR;
#undef PG8_ABASE
#undef PG8_BBASE
#undef PG8_SA
#undef PG8_SB
#undef PG8_STAGE
#undef PG8_LDA
#undef PG8_LDB
#undef PG8_MMA
#undef PG8_WAIT_V
#undef PG8_WAIT_L
#undef PG8_BAR
#undef PG8_SCHED
}

struct EpiRes {
    static constexpr bool PERM = false;
    const float* xin_p; const float* xin_s;
    float* Y; const float* scale; float* slab;
    __device__ __forceinline__ void operator()(const f32x4 (&acc)[2][2][4][2], const Unit& u, int wr, int wc, int fr, int fq, LAS unsigned char*) const {
        const int row0 = u.pm * BM + wr * 128 + fr, col0 = u.pn * BM + wc * 32 + 4 * fq;
        const float* xb = (u.pm < 32) ? xin_p + (size_t)row0 * DM : xin_s + (size_t)(row0 - SEQ) * DM;
        if (u.kc >= 0) {
            float* sb = slab + ((size_t)u.kc * NSAMP + (row0 - SEQ)) * DM;
#pragma unroll
            for (int ai = 0; ai < 2; ++ai)
#pragma unroll
                for (int m = 0; m < 4; ++m) { const size_t ro = (size_t)(ai * 64 + m * 16) * DM + col0;
#pragma unroll
                    for (int bj = 0; bj < 2; ++bj)
#pragma unroll
                        for (int n = 0; n < 2; ++n) *(f32x4*)(sb + ro + bj * HALF + n * 16) = acc[ai][bj][m][n]; }
            return;
        }
        float* yb = Y + (size_t)row0 * DM;
        f32x4 sv[2][2];
#pragma unroll
        for (int bj = 0; bj < 2; ++bj)
#pragma unroll
            for (int n = 0; n < 2; ++n) sv[bj][n] = scale ? *(const f32x4*)(scale + col0 + bj * HALF + n * 16) : (f32x4){1.f, 1.f, 1.f, 1.f};
#pragma unroll
        for (int ai = 0; ai < 2; ++ai)
#pragma unroll
            for (int m = 0; m < 4; ++m) { const size_t ro = (size_t)(ai * 64 + m * 16) * DM + col0;
#pragma unroll
                for (int bj = 0; bj < 2; ++bj)
#pragma unroll
                    for (int n = 0; n < 2; ++n) { const f32x4 xv = *(const f32x4*)(xb + ro + bj * HALF + n * 16);
                        *(f32x4*)(yb + ro + bj * HALF + n * 16) = xv * ALPHA + acc[ai][bj][m][n] * sv[bj][n]; } }
    }
};
struct EpiKVQ {
    static constexpr bool PERM = true;
    float* kout_p; float* kout_s; bf16_t* Kb; int base_which;
    __device__ __forceinline__ void operator()(const f32x4 (&acc)[2][2][4][2], const Unit& u, int wr, int wc, int fr, int fq, LAS unsigned char*) const {
        const int row0 = u.pm * BM + wr * 128 + fr; int colt = u.pn * BM; const int which = base_which + colt / DM; colt -= (colt / DM) * DM;
        const int col0 = colt + wc * 32 + 8 * fq;
        bf16_t* ob = Kb + (size_t)which * ((size_t)MROWS * DM) + (size_t)row0 * DM + col0;
        float* fo = nullptr;
        if (which < 2) fo = (u.pm < 32) ? kout_p + (size_t)which * ((size_t)SEQ * DM) + (size_t)row0 * DM : kout_s + (size_t)which * ((size_t)NSAMP * DM) + (size_t)(row0 - SEQ) * DM;
        const float s = which == 2 ? QSCALE : 1.f;
#pragma unroll
        for (int ai = 0; ai < 2; ++ai)
#pragma unroll
            for (int m = 0; m < 4; ++m) { const size_t ro = (size_t)(ai * 64 + m * 16) * DM;
#pragma unroll
                for (int bj = 0; bj < 2; ++bj) { const f32x4 v0 = acc[ai][bj][m][0] * s, v1 = acc[ai][bj][m][1] * s;
                    u32x4 w; w.x = cvt_pk_bf16(v0[0], v0[1]); w.y = cvt_pk_bf16(v0[2], v0[3]); w.z = cvt_pk_bf16(v1[0], v1[1]); w.w = cvt_pk_bf16(v1[2], v1[3]);
                    *(u32x4*)(ob + ro + bj * HALF) = w;
                    if (fo) { *(f32x4*)(fo + ro + col0 + bj * HALF) = v0; *(f32x4*)(fo + ro + col0 + bj * HALF + 4) = v1; } } }
    }
};
constexpr int EXCH_OFF = 131072;
__device__ __forceinline__ float dpp_ror1(float x) { return __builtin_bit_cast(float, __builtin_amdgcn_update_dpp(0, __builtin_bit_cast(int, x), 0x121, 0xf, 0xf, false)); }
__device__ __forceinline__ float dpp_ror2(float x) { return __builtin_bit_cast(float, __builtin_amdgcn_update_dpp(0, __builtin_bit_cast(int, x), 0x122, 0xf, 0xf, false)); }
__device__ __forceinline__ float dpp_shr1(float old, float x) { return __builtin_bit_cast(float, __builtin_amdgcn_update_dpp(__builtin_bit_cast(int, old), __builtin_bit_cast(int, x), 0x111, 0xf, 0xf, false)); }
__device__ __forceinline__ float dpp_shr2(float old, float x) { return __builtin_bit_cast(float, __builtin_amdgcn_update_dpp(__builtin_bit_cast(int, old), __builtin_bit_cast(int, x), 0x112, 0xf, 0xf, false)); }
__device__ __forceinline__ float gelu_tanh(float a) {
    const float K2 = -2.3022081986f;
    const float z = a * __builtin_fmaf(a * a, K2 * 0.044715f, K2);
    return a * __builtin_amdgcn_rcpf(1.0f + __builtin_amdgcn_exp2f(z));
}
struct EpiUp {
    static constexpr bool PERM = true;
    const float* cw; const float* cb; const float* hist;
    bf16_t* G; float* hhead; float* htail;
    float* conv_p; float* conv_s;
    __device__ __forceinline__ void operator()(const f32x4 (&acc)[2][2][4][2], const Unit& u, int wr, int wc, int fr, int fq, LAS unsigned char*) const {
        const int f0 = u.pn * HALF + wc * 32 + 8 * fq;
        const bool sample = u.pm >= 32;
        const int hp = u.pm * 2 + wr;
        if (!sample) {
            if (fr < 2) {
#pragma unroll
                for (int bj = 0; bj < 2; ++bj)
#pragma unroll
                    for (int n = 0; n < 2; ++n) *(f32x4*)(hhead + (size_t)(hp * 2 + fr) * NUP + bj * DFF + f0 + 4 * n) = acc[0][bj][0][n];
            }
            if (fr >= 14) {
#pragma unroll
                for (int bj = 0; bj < 2; ++bj)
#pragma unroll
                    for (int n = 0; n < 2; ++n) { *(f32x4*)(htail + (size_t)(hp * 2 + fr - 14) * NUP + bj * DFF + f0 + 4 * n) = acc[1][bj][3][n];
                        if (hp == 63) *(f32x4*)(conv_p + (size_t)(fr - 14) * NUP + bj * DFF + f0 + 4 * n) = acc[1][bj][3][n]; }
            }
        }
#define UP_CONV_STORE(PV0, PV1, SKIPC) do { f32x4 c_[2]; const f32x4 pv_[2] = {PV0, PV1}; \
            _Pragma("unroll") for (int bj = 0; bj < 2; ++bj) _Pragma("unroll") for (int j = 0; j < 4; ++j) { const float h = acc[ai][bj][m][n][j], p = pv_[bj][j]; \
                const float hm1 = dpp_shr1(dpp_ror1(p), h), hm2 = dpp_shr2(dpp_ror2(p), h); \
                c_[bj][j] = CB[bj][j] + W2[bj][j] * h + W1[bj][j] * hm1 + W0[bj][j] * hm2; } \
            u32x2 w_; w_.x = cvt_pk_bf16(gelu_tanh(c_[0][0]) * c_[1][0], gelu_tanh(c_[0][1]) * c_[1][1]); w_.y = cvt_pk_bf16(gelu_tanh(c_[0][2]) * c_[1][2], gelu_tanh(c_[0][3]) * c_[1][3]); \
            if (!(SKIPC)) *(u32x2*)(grow + (size_t)(ai * 64 + m * 16) * DFF + 4 * n) = w_; } while (0)
        bf16_t* grow = G + (size_t)(u.pm * BM + wr * 128 + fr) * DFF + f0;
        const f32x4 z4 = (f32x4){0.f, 0.f, 0.f, 0.f};
        if (!sample) {
#pragma unroll
            for (int n = 0; n < 2; ++n) {
                __builtin_amdgcn_sched_barrier(0);
                f32x4 W0[2], W1[2], W2[2], CB[2];
#pragma unroll
                for (int bj = 0; bj < 2; ++bj) { const int col = bj * DFF + f0 + 4 * n;
                    W0[bj] = *(const f32x4*)(cw + col); W1[bj] = *(const f32x4*)(cw + NUP + col); W2[bj] = *(const f32x4*)(cw + 2 * NUP + col); CB[bj] = *(const f32x4*)(cb + col); }
#pragma unroll
                for (int ai = 0; ai < 2; ++ai)
#pragma unroll
                    for (int m = 0; m < 4; ++m) {
                        if (m > 0) UP_CONV_STORE(acc[ai][0][m - 1][n], acc[ai][1][m - 1][n], false);
                        else if (ai == 1) UP_CONV_STORE(acc[0][0][3][n], acc[0][1][3][n], false);
                        else UP_CONV_STORE(z4, z4, (hp > 0 && fr < 2));
                    }
            }
        } else {
            const int hrow = fr >= 14 ? fr - 14 : 0;
            const int b0 = (u.pm - 32) * 16 + wr * 8;
#pragma unroll
            for (int n = 0; n < 2; ++n) {
                __builtin_amdgcn_sched_barrier(0);
                f32x4 W0[2], W1[2], W2[2], CB[2];
#pragma unroll
                for (int bj = 0; bj < 2; ++bj) { const int col = bj * DFF + f0 + 4 * n;
                    W0[bj] = *(const f32x4*)(cw + col); W1[bj] = *(const f32x4*)(cw + NUP + col); W2[bj] = *(const f32x4*)(cw + 2 * NUP + col); CB[bj] = *(const f32x4*)(cb + col); }
#pragma unroll
                for (int ai = 0; ai < 2; ++ai)
#pragma unroll
                    for (int m = 0; m < 4; ++m) {
                        __builtin_amdgcn_sched_barrier(0);
                        const f32x4 hv0 = *(const f32x4*)(hist + (size_t)((b0 + 4 * ai + m) * 2 + hrow) * NUP + f0 + 4 * n);
                        const f32x4 hv1 = *(const f32x4*)(hist + (size_t)((b0 + 4 * ai + m) * 2 + hrow) * NUP + DFF + f0 + 4 * n);
                        UP_CONV_STORE(hv0, hv1, false);
                        if (fr >= 14) {
#pragma unroll
                            for (int bj = 0; bj < 2; ++bj) *(f32x4*)(conv_s + (size_t)((b0 + 4 * ai + m) * 2 + fr - 14) * NUP + bj * DFF + f0 + 4 * n) = acc[ai][bj][m][n];
                        }
                    }
            }
        }
#undef UP_CONV_STORE
    }
};
}

constexpr int NWAVES = 8;
constexpr size_t MiB = 1u << 20;
constexpr size_t WS_CTL = 0, CTL_ZERO_BYTES = 1 * MiB;
constexpr size_t SZ_ACT_F32 = (size_t)MROWS * DM * 4, SZ_ACT_BF = (size_t)MROWS * DM * 2;
constexpr size_t WS_WUP = 2 * MiB;
constexpr size_t WS_WDN = WS_WUP + (size_t)4 * NUP * DM * 2;
constexpr size_t WS_WKVQ = WS_WDN + (size_t)4 * DM * DFF * 2;
constexpr size_t WS_WQ3 = WS_WKVQ + (size_t)6144 * DM * 2;
constexpr size_t WS_WO = WS_WQ3 + (size_t)DM * DM * 2;
constexpr size_t WS_WPOOL = WS_WO + (size_t)2 * DM * DM * 2;
constexpr size_t WS_X = WS_WPOOL + (size_t)2 * DM * 512 * 2;
constexpr size_t WS_Y = WS_X + SZ_ACT_F32;
constexpr size_t WS_XN = WS_Y + SZ_ACT_F32;
constexpr size_t WS_DIN = WS_XN + SZ_ACT_BF;
constexpr size_t WS_G = WS_DIN + SZ_ACT_BF;
constexpr size_t WS_HH = WS_G + (size_t)MROWS * DFF * 2;
constexpr size_t WS_HT = WS_HH + (size_t)64 * 2 * NUP * 4;
constexpr size_t WS_KB = WS_HT + (size_t)64 * 2 * NUP * 4;
constexpr size_t WS_VB = WS_KB + SZ_ACT_BF, WS_QB = WS_VB + SZ_ACT_BF, WS_OB = WS_QB + SZ_ACT_BF, WS_SLAB = WS_OB + SZ_ACT_BF;
constexpr int KSPLIT_MAX = 11;
constexpr size_t WS_END = WS_SLAB + (size_t)KSPLIT_MAX * NSAMP * DM * 4;
constexpr size_t O_Y = 0, O_POOLP = 17825792, O_POOLS = 17887232, O_CONVP = 19853312, O_CONVS = 19943424, O_KP = 22827008, O_VP = 39604224, O_KS = 56381440, O_VS = 57430016;
constexpr int LDS_ML = 139264, MISC_OFF = 147456, LDS_BYTES = 147456 + 256;
constexpr int CW_BAR = 4096;

typedef GAS unsigned gu32;
#define RLX_AGENT __ATOMIC_RELAXED, __HIP_MEMORY_SCOPE_AGENT
#define LDS_WAIT() asm volatile("s_waitcnt lgkmcnt(0)" ::: "memory")
#define VM_WAIT() asm volatile("s_waitcnt vmcnt(0)" ::: "memory")

#define XB_TMO      128
#define XB_XCNT(j)  (256  + 64 * (j))
#define XB_XSUB(j)  (1280 + 64 * (j))
#define XB_XGEN(j)  (2304 + 64 * (j))
#define XB_TOP      3328
#define XB_TOPGEN   3392
#define XCD_BAR_WORDS 3456
#define XB_SPIN_CAP (1u << 18)
__device__ __forceinline__ unsigned xb_ld(unsigned* p)              { return __hip_atomic_load(p, __ATOMIC_RELAXED, __HIP_MEMORY_SCOPE_AGENT); }
__device__ __forceinline__ unsigned xb_add(unsigned* p, unsigned v) { return __hip_atomic_fetch_add(p, v, __ATOMIC_RELAXED, __HIP_MEMORY_SCOPE_AGENT); }
__device__ __forceinline__ unsigned xb_xcc_id() { return (unsigned)__builtin_amdgcn_s_getreg((3 << 11) | 20) & 0xFu; }
#define XB_SPIN(cond, bar) do { unsigned _sp = 0; while (cond) { __builtin_amdgcn_s_sleep(1); \
    if ((++_sp & 255u) == 0u) { if (xb_ld(&(bar)[XB_TMO])) break; if (_sp > XB_SPIN_CAP) { atomicAdd(&(bar)[XB_TMO], 1u); break; } } } } while (0)
struct XcdBarrier { unsigned* bar; unsigned x; volatile LAS unsigned* st; };
__device__ __forceinline__ XcdBarrier xcd_barrier_post(unsigned* bar, volatile LAS unsigned* st) {
    XcdBarrier b; b.bar = bar; b.x = xb_xcc_id(); b.st = st;
    if (threadIdx.x == 0) (void)xb_add(&bar[XB_XCNT(b.x)], 1u);
    return b;
}
__device__ __forceinline__ void xcd_barrier_complete(unsigned* bar, unsigned x, unsigned& nloc, unsigned& nx) {
    const unsigned G = gridDim.x * gridDim.y * gridDim.z;
    unsigned sum, cnt, mine, sp = 0u;
    for (;;) {
        sum = 0u; cnt = 0u; mine = 0u;
#pragma unroll
        for (unsigned j = 0; j < 16; ++j) { const unsigned c = xb_ld(&bar[XB_XCNT(j)]); sum += c; cnt += (c > 0u) ? 1u : 0u; mine = (j == x) ? c : mine; }
        if (sum == G) break;
        __builtin_amdgcn_s_sleep(1);
        if ((++sp & 255u) == 0u) { if (xb_ld(&bar[XB_TMO])) break; if (sp > XB_SPIN_CAP) { atomicAdd(&bar[XB_TMO], 1u); break; } }
    }
    nloc = mine > 0u ? mine : 1u; nx = cnt > 0u ? cnt : 1u;
}
__device__ __forceinline__ void xcd_barrier(const XcdBarrier& b, int tid_now) {
    asm volatile("s_waitcnt vmcnt(0)" ::: "memory");
    __syncthreads();
    if (tid_now == 0) {
        unsigned* bar = b.bar;
        __builtin_amdgcn_s_waitcnt(0);
        unsigned nloc = b.st[0], nx = b.st[1];
        if (nloc == 0u) { xcd_barrier_complete(bar, b.x, nloc, nx); b.st[0] = nloc; b.st[1] = nx; }
        const unsigned old = xb_add(&bar[XB_XSUB(b.x)], 1u);
        const unsigned gen = old / nloc;
        if (old + 1u == (gen + 1u) * nloc) {
            __builtin_amdgcn_fence(__ATOMIC_RELEASE, "agent");
            asm volatile("s_waitcnt vmcnt(0)" ::: "memory");
            const unsigned og = xb_add(&bar[XB_TOP], 1u);
            const unsigned tg = og / nx;
            if (og + 1u == (tg + 1u) * nx) xb_add(&bar[XB_TOPGEN], 1u);
            else XB_SPIN(xb_ld(&bar[XB_TOPGEN]) == tg, bar);
            __builtin_amdgcn_fence(__ATOMIC_ACQUIRE, "agent");
            xb_add(&bar[XB_XGEN(b.x)], 1u);
            asm volatile("s_waitcnt vmcnt(0)" ::: "memory");
        } else {
            XB_SPIN(xb_ld(&bar[XB_XGEN(b.x)]) == gen, bar);
            __builtin_amdgcn_fence(__ATOMIC_ACQUIRE, "agent");
            asm volatile("s_waitcnt vmcnt(0)" ::: "memory");
        }
    }
    __syncthreads();
}

struct Args {
    const float* in[21]; float* out; unsigned char* ws; int ph_lo, ph_hi;
};

__device__ __forceinline__ float shx(float v, int o, int lane) { return __builtin_bit_cast(float, __builtin_amdgcn_ds_bpermute((lane ^ o) << 2, __builtin_bit_cast(int, v))); }
__device__ __forceinline__ float wave_sum(float v, int lane) {
#pragma unroll
    for (int o = 1; o < 64; o <<= 1) v += shx(v, o, lane);
    return v;
}

__device__ __forceinline__ void transpose_item(const float* W, int K, int N, bf16_t* WT, int row_off, int mode, LAS float* scr, int item, int lane) {
    const int nblk = N / 32, kb = item / nblk, nb = item % nblk, k0 = 64 * kb, n0 = 32 * nb;
#pragma unroll 8
    for (int i = 0; i < 32; ++i) { const int kk = 2 * i + (lane >> 5); scr[kk * 33 + (lane & 31)] = W[(size_t)(k0 + kk) * N + n0 + (lane & 31)]; }
    LDS_WAIT(); asm volatile("" ::: "memory");
    int d0 = n0;
    if (mode == 1) d0 = (n0 < DFF) ? 256 * (n0 / 128) + (n0 % 128) : 256 * ((n0 - DFF) / 128) + 128 + ((n0 - DFF) % 128);
    const int c = lane & 7;
#pragma unroll
    for (int j = 0; j < 4; ++j) { const int n = (lane >> 3) + 8 * j; const LAS float* s = scr + (8 * c) * 33 + n;
        u32x4 o; o.x = cvt_pk_bf16(s[0 * 33], s[1 * 33]); o.y = cvt_pk_bf16(s[2 * 33], s[3 * 33]); o.z = cvt_pk_bf16(s[4 * 33], s[5 * 33]); o.w = cvt_pk_bf16(s[6 * 33], s[7 * 33]);
        *(u32x4*)(WT + (size_t)(row_off + d0 + n) * K + k0 + 8 * c) = o; }
    LDS_WAIT(); asm volatile("" ::: "memory");
}

template <int W>
__device__ __forceinline__ void pooldiff_rows2(const float* xrow0  , const float* histrow  ,
                                               int r0, bool sample, bf16_t* dout  ) {
    constexpr int WM = W - 1;
    f32x4 hbuf[WM]; f32x4 S = (f32x4){0.f, 0.f, 0.f, 0.f};
#pragma unroll
    for (int k = 0; k < WM; ++k) {
        const int t = r0 - WM + k; f32x4 v = (f32x4){0.f, 0.f, 0.f, 0.f};
        if (sample) v = *(const f32x4*)(histrow + (size_t)(15 - WM + k) * DM);
        else if (t >= 0) v = *(const f32x4*)(xrow0 + (ptrdiff_t)(k - WM) * DM);
        hbuf[k] = v; S += v;
    }
#pragma unroll
    for (int it = 0; it < 16; ++it) {
        const f32x4 x = *(const f32x4*)(xrow0 + (size_t)it * DM);
        const f32x4 T = S + x;
        const int pos = r0 + it;
        const float cnt = sample ? (float)W : (float)((pos + 1 < W) ? pos + 1 : W);
        const f32x4 d = T / cnt - x;
        u32x2 o; o.x = cvt_pk_bf16(d[0], d[1]); o.y = cvt_pk_bf16(d[2], d[3]);
        *(u32x2*)(dout + (size_t)it * DM) = o;
        S = T - hbuf[it % WM]; hbuf[it % WM] = x;
    }
}

namespace att {
__device__ __forceinline__ int crow(int r, int hi) { return (r & 3) + 8 * (r >> 2) + 4 * hi; }
__device__ __forceinline__ s16x4 vtr(const LAS char* p) { typedef short v4i16_t __attribute__((ext_vector_type(4)));
    return __builtin_bit_cast(s16x4, __builtin_amdgcn_ds_read_tr16_b64_v4i16((LAS v4i16_t*)p)); }
__device__ __forceinline__ float swapmax(float m) { auto rr = __builtin_amdgcn_permlane32_swap(__float_as_uint(m), __float_as_uint(m), false, false); return fmaxf(__uint_as_float(rr[0]), __uint_as_float(rr[1])); }
__device__ __forceinline__ float swapsum(float m) { auto rr = __builtin_amdgcn_permlane32_swap(__float_as_uint(m), __float_as_uint(m), false, false); return __uint_as_float(rr[0]) + __uint_as_float(rr[1]); }
constexpr float THR = 8.0f;
constexpr int AK = 0, AV = 32768, AWSF = 65536, AQ = 67584;

__device__ __forceinline__ void prompt_unit(int h, int qb, const bf16_t* Qb, const bf16_t* Kb, const bf16_t* Vb, bf16_t* Ob, float lam, const float* subg, float oscale, LAS unsigned char* lds, int tid_in) {
    int tid_ = tid_in; asm volatile("" : "+v"(tid_));
    const int tid = tid_, lane = tid & 63, r32 = lane & 31, hi = lane >> 5, wid = __builtin_amdgcn_readfirstlane(tid >> 6);
    const int q0 = qb * 256, NT = 4 * qb + 4, my_nt = 4 * qb + (wid >> 1) + 1;
    LAS char* qlds = (LAS char*)(lds + AQ + wid * 8192) + lane * 16;
    { const bf16_t* qrow = Qb + (size_t)(q0 + 32 * wid + r32) * DM + h * 128;
#pragma unroll
      for (int i = 0; i < 2; ++i)
#pragma unroll
          for (int d0 = 0; d0 < 4; ++d0) *(LAS bf16x8*)(qlds + (4 * i + d0) * 1024) = *(const bf16x8*)(qrow + 64 * i + 16 * d0 + 8 * hi); }
    f32x16 o1[4], o2[4];
#pragma unroll
    for (int d = 0; d < 4; ++d) { o1[d] = f32x16{}; o2[d] = f32x16{}; }
    float m1 = -1e30f, m2 = -1e30f, l1 = 0.f, l2 = 0.f;
    LAS float* wsf = (LAS float*)(lds + AWSF) + wid * 64;
    const int st0 = 2 * wid, st1 = 2 * wid + 1;
    const bf16_t* ksrc = Kb + (size_t)lane * DM + h * 128 + st0 * 8;
    const bf16_t* vsrc0 = Vb + (size_t)(16 * (st0 & 3) + (lane >> 2)) * DM + h * 128 + (st0 >> 2) * 32 + (lane & 3) * 8;
    const bf16_t* vsrc1 = Vb + (size_t)(16 * (st1 & 3) + (lane >> 2)) * DM + h * 128 + (st1 >> 2) * 32 + (lane & 3) * 8;
#define ATT_DMA(t, b) do { const size_t ro_ = (size_t)(t) * 64 * DM; \
        __builtin_amdgcn_global_load_lds((const unsigned*)(ksrc + ro_), (LAS unsigned*)(lds + AK + (b) * 16384 + st0 * 1024), 16, 0, 0); \
        __builtin_amdgcn_global_load_lds((const unsigned*)(ksrc + ro_ + 8), (LAS unsigned*)(lds + AK + (b) * 16384 + st1 * 1024), 16, 0, 0); \
        __builtin_amdgcn_global_load_lds((const unsigned*)(vsrc0 + ro_), (LAS unsigned*)(lds + AV + (b) * 16384 + st0 * 1024), 16, 0, 0); \
        __builtin_amdgcn_global_load_lds((const unsigned*)(vsrc1 + ro_), (LAS unsigned*)(lds + AV + (b) * 16384 + st1 * 1024), 16, 0, 0); } while (0)
    const int voff = ((lane >> 4) & 1) * 32 + (lane & 3) * 8 + (4 * hi + ((lane & 15) >> 2)) * 64;
    ATT_DMA(0, 0);
    for (int t = 0; t < NT; ++t) {
        const int b = t & 1;
        if (t + 1 < NT) { ATT_DMA(t + 1, b ^ 1); asm volatile("s_waitcnt vmcnt(4)" ::: "memory"); } else { asm volatile("s_waitcnt vmcnt(0)" ::: "memory"); }
        __builtin_amdgcn_s_barrier(); asm volatile("" ::: "memory");
        if (t < my_nt) {
            const LAS char* Kt = (const LAS char*)(lds + AK + b * 16384); const LAS char* Vt = (const LAS char*)(lds + AV + b * 16384);
            u32x4 pa[2][4];
#pragma unroll
            for (int i = 0; i < 2; ++i) {
                __builtin_amdgcn_sched_barrier(0);
                f32x16 p0 = f32x16{}, p1 = f32x16{};
#pragma unroll
                for (int d0 = 0; d0 < 4; ++d0) {
                    const bf16x8 qv = *(const LAS bf16x8*)(qlds + (4 * i + d0) * 1024);
                    const bf16x8 k0 = *(const LAS bf16x8*)(Kt + (8 * i + 2 * d0 + hi) * 1024 + r32 * 16);
                    const bf16x8 k1 = *(const LAS bf16x8*)(Kt + (8 * i + 2 * d0 + hi) * 1024 + 512 + r32 * 16);
                    p0 = __builtin_amdgcn_mfma_f32_32x32x16_bf16(k0, qv, p0, 0, 0, 0);
                    p1 = __builtin_amdgcn_mfma_f32_32x32x16_bf16(k1, qv, p1, 0, 0, 0);
                }
                __builtin_amdgcn_sched_barrier(0);
                float rm = fmaxf(p0[0], p1[0]);
#pragma unroll
                for (int r = 1; r < 16; ++r) rm = fmaxf(rm, fmaxf(p0[r], p1[r]));
                rm = swapmax(rm);
                float mref = i ? m2 : m1;
                if (__any(rm > mref + THR)) {
                    const float mn = fmaxf(mref, rm), alpha = __builtin_amdgcn_exp2f(mref - mn);
                    mref = mn; if (i) { m2 = mn; l2 *= alpha; } else { m1 = mn; l1 *= alpha; }
                    if (hi == 0) wsf[r32] = alpha;
                    LDS_WAIT();
#pragma unroll
                    for (int r = 0; r < 16; ++r) { const float f = wsf[crow(r, hi)];
#pragma unroll
                        for (int d = 0; d < 4; ++d) { if (i) o2[d][r] *= f; else o1[d][r] *= f; } }
                    LDS_WAIT();
                }
                float ls = 0.f;
#pragma unroll
                for (int r = 0; r < 16; ++r) { p0[r] = __builtin_amdgcn_exp2f(p0[r] - mref); p1[r] = __builtin_amdgcn_exp2f(p1[r] - mref); ls += p0[r] + p1[r]; }
                if (i) l2 += ls; else l1 += ls;
#pragma unroll
                for (int s = 0; s < 2; ++s) {
                    pa[i][s] = (u32x4){cvt_pk_bf16(p0[8 * s], p0[8 * s + 1]), cvt_pk_bf16(p0[8 * s + 2], p0[8 * s + 3]), cvt_pk_bf16(p0[8 * s + 4], p0[8 * s + 5]), cvt_pk_bf16(p0[8 * s + 6], p0[8 * s + 7])};
                    pa[i][2 + s] = (u32x4){cvt_pk_bf16(p1[8 * s], p1[8 * s + 1]), cvt_pk_bf16(p1[8 * s + 2], p1[8 * s + 3]), cvt_pk_bf16(p1[8 * s + 4], p1[8 * s + 5]), cvt_pk_bf16(p1[8 * s + 6], p1[8 * s + 7])};
                }
            }
#pragma unroll
            for (int d = 0; d < 4; ++d) {
                __builtin_amdgcn_sched_barrier(0);
                bf16x8 vf[4];
#pragma unroll
                for (int s = 0; s < 4; ++s) { const s16x4 lo = vtr(Vt + d * 4096 + s * 1024 + voff), hh = vtr(Vt + d * 4096 + s * 1024 + 512 + voff);
                    vf[s] = (bf16x8){lo[0], lo[1], lo[2], lo[3], hh[0], hh[1], hh[2], hh[3]}; }
#pragma unroll
                for (int s = 0; s < 4; ++s) {
                    o1[d] = __builtin_amdgcn_mfma_f32_32x32x16_bf16(__builtin_bit_cast(bf16x8, pa[0][s]), vf[s], o1[d], 0, 0, 0);
                    o2[d] = __builtin_amdgcn_mfma_f32_32x32x16_bf16(__builtin_bit_cast(bf16x8, pa[1][s]), vf[s], o2[d], 0, 0, 0);
                }
            }
        }
        LDS_WAIT(); __builtin_amdgcn_s_barrier(); asm volatile("" ::: "memory");
    }
#undef ATT_DMA
    l1 = swapsum(l1); l2 = swapsum(l2);
    if (hi == 0) { wsf[r32] = 1.0f / l1; wsf[32 + r32] = lam / l2; }
    LDS_WAIT();
    float gsc[4];
#pragma unroll
    for (int d = 0; d < 4; ++d) gsc[d] = subg[32 * d + r32] * oscale;
    bf16_t* ob = Ob + (size_t)(q0 + 32 * wid) * DM + h * 128 + r32;
#pragma unroll
    for (int r = 0; r < 16; ++r) {
        const int q = crow(r, hi); const float a = wsf[q], bb = wsf[32 + q];
        float v[4], ss = 0.f;
#pragma unroll
        for (int d = 0; d < 4; ++d) { v[d] = o1[d][r] * a - o2[d][r] * bb; ss += v[d] * v[d]; }
#pragma unroll
        for (int o = 1; o < 32; o <<= 1) ss += shx(ss, o, lane);
        const float rs = 1.0f / sqrtf(ss * (1.0f / 128.0f) + LN_EPS);
#pragma unroll
        for (int d = 0; d < 4; ++d) ob[(size_t)q * DM + 32 * d] = f2bf(v[d] * rs * gsc[d]);
    }
    LDS_WAIT();
}

__device__ __forceinline__ bf16x8 pack8(f32x4 a, f32x4 b) { u32x4 w; w.x = cvt_pk_bf16(a[0], a[1]); w.y = cvt_pk_bf16(a[2], a[3]); w.z = cvt_pk_bf16(b[0], b[1]); w.w = cvt_pk_bf16(b[2], b[3]); return __builtin_bit_cast(bf16x8, w); }
__device__ __forceinline__ void sample_unit(int b, int h, const bf16_t* Qb, const float* cache_k, const float* cache_v, const float* knew, const float* vnew, bf16_t* Ob,
                                            float lam, const float* subg, float oscale, LAS unsigned char* lds, int tid_in) {
    int tid_ = tid_in; asm volatile("" : "+v"(tid_));
    const int tid = tid_, lane = tid & 63, q = lane & 15, g = lane >> 4, wid = __builtin_amdgcn_readfirstlane(tid >> 6);
    bf16x8 qf[2][2];
    { const bf16_t* qrow = Qb + (size_t)(SEQ + 16 * b + q) * DM + h * 128;
#pragma unroll
      for (int i = 0; i < 2; ++i)
#pragma unroll
          for (int ks = 0; ks < 2; ++ks) qf[i][ks] = *(const bf16x8*)(qrow + 64 * i + 32 * ks + 8 * g); }
    f32x4 o[2][8];
#pragma unroll
    for (int i = 0; i < 2; ++i)
#pragma unroll
        for (int c = 0; c < 8; ++c) o[i][c] = (f32x4){0.f, 0.f, 0.f, 0.f};
    float mm[2] = {-1e30f, -1e30f}, ll[2] = {0.f, 0.f};
    const int npair = (wid == 7) ? 5 : 4;
    for (int p = 0; p < npair; ++p) {
        const float *k0, *k1, *v0, *v1; const bool dummy1 = (p >= 4);
        if (!dummy1) { const size_t kv = (size_t)128 * wid + 32 * p; const size_t off = ((size_t)(b * PAST + kv) * NHEAD + h) * 128;
            k0 = cache_k + off; k1 = k0 + (size_t)16 * DM; v0 = cache_v + off; v1 = v0 + (size_t)16 * DM; }
        else { const size_t off = (size_t)(16 * b) * DM + h * 128; k0 = knew + off; k1 = k0; v0 = vnew + off; v1 = v0; }
        bf16x8 kf[2][4];
#pragma unroll
        for (int blk = 0; blk < 2; ++blk)
#pragma unroll
            for (int ks = 0; ks < 4; ++ks) { const float* pp = (blk ? k1 : k0) + (size_t)q * DM + 32 * ks + 8 * g; kf[blk][ks] = pack8(*(const f32x4*)pp, *(const f32x4*)(pp + 4)); }
        f32x4 st[2][2];
#pragma unroll
        for (int i = 0; i < 2; ++i)
#pragma unroll
            for (int blk = 0; blk < 2; ++blk) {
                st[i][blk] = __builtin_amdgcn_mfma_f32_16x16x32_bf16(kf[blk][2 * i], qf[i][0], (f32x4){0.f, 0.f, 0.f, 0.f}, 0, 0, 0);
                st[i][blk] = __builtin_amdgcn_mfma_f32_16x16x32_bf16(kf[blk][2 * i + 1], qf[i][1], st[i][blk], 0, 0, 0);
                if (blk == 1 && dummy1) st[i][blk] = (f32x4){-1e30f, -1e30f, -1e30f, -1e30f};
            }
        bf16x8 pf[2];
#pragma unroll
        for (int i = 0; i < 2; ++i) {
            float rm = fmaxf(fmaxf(fmaxf(st[i][0][0], st[i][0][1]), fmaxf(st[i][0][2], st[i][0][3])), fmaxf(fmaxf(st[i][1][0], st[i][1][1]), fmaxf(st[i][1][2], st[i][1][3])));
            rm = fmaxf(rm, shx(rm, 16, lane)); rm = fmaxf(rm, shx(rm, 32, lane));
            if (__any(rm > mm[i] + THR)) { const float mn = fmaxf(mm[i], rm), alpha = __builtin_amdgcn_exp2f(mm[i] - mn); mm[i] = mn; ll[i] *= alpha;
#pragma unroll
                for (int c = 0; c < 8; ++c) o[i][c] *= alpha; }
            f32x4 e0, e1;
#pragma unroll
            for (int j = 0; j < 4; ++j) { e0[j] = __builtin_amdgcn_exp2f(st[i][0][j] - mm[i]); e1[j] = __builtin_amdgcn_exp2f(st[i][1][j] - mm[i]); }
            ll[i] += (e0[0] + e0[1]) + (e0[2] + e0[3]) + (e1[0] + e1[1]) + (e1[2] + e1[3]);
            pf[i] = pack8(e0, e1);
        }
#pragma unroll
        for (int dh = 0; dh < 2; ++dh) {
            f32x4 vl[8];
#pragma unroll
            for (int j = 0; j < 8; ++j) { const float* vp = (j < 4 ? v0 + (size_t)(4 * g + j) * DM : v1 + (size_t)(4 * g + j - 4) * DM) + 64 * dh + 4 * q; vl[j] = *(const f32x4*)vp; }
#pragma unroll
            for (int cc = 0; cc < 4; ++cc) {
                u32x4 w; w.x = cvt_pk_bf16(vl[0][cc], vl[1][cc]); w.y = cvt_pk_bf16(vl[2][cc], vl[3][cc]); w.z = cvt_pk_bf16(vl[4][cc], vl[5][cc]); w.w = cvt_pk_bf16(vl[6][cc], vl[7][cc]);
                const bf16x8 vf = __builtin_bit_cast(bf16x8, w);
#pragma unroll
                for (int i = 0; i < 2; ++i) o[i][4 * dh + cc] = __builtin_amdgcn_mfma_f32_16x16x32_bf16(vf, pf[i], o[i][4 * dh + cc], 0, 0, 0);
            }
        }
    }
    LAS float* ML = (LAS float*)(lds + LDS_ML);
    LAS float* slab = (LAS float*)lds;
#pragma unroll
    for (int i = 0; i < 2; ++i) { ll[i] += shx(ll[i], 16, lane); ll[i] += shx(ll[i], 32, lane);
        if (g == 0) { ML[((wid * 2 + i) * 16 + q) * 2] = mm[i]; ML[((wid * 2 + i) * 16 + q) * 2 + 1] = ll[i]; } }
    LDS_WAIT(); __builtin_amdgcn_s_barrier(); asm volatile("" ::: "memory");
#pragma unroll
    for (int i = 0; i < 2; ++i) {
        float M = -1e30f;
#pragma unroll
        for (int w = 0; w < 8; ++w) M = fmaxf(M, ML[((w * 2 + i) * 16 + q) * 2]);
        const float f = __builtin_amdgcn_exp2f(mm[i] - M);
#pragma unroll
        for (int c = 0; c < 8; ++c) *(LAS f32x4*)(slab + ((wid * 2 + i) * 16 + q) * 132 + c * 16 + 4 * g) = o[i][c] * f;
    }
    LDS_WAIT(); __builtin_amdgcn_s_barrier(); asm volatile("" ::: "memory");
    {
        const int qq = lane >> 5, ln = lane & 31, qfin = 2 * wid + qq;
        float L[2]; f32x4 s[2];
#pragma unroll
        for (int i = 0; i < 2; ++i) {
            float M = -1e30f;
#pragma unroll
            for (int w = 0; w < 8; ++w) M = fmaxf(M, ML[((w * 2 + i) * 16 + qfin) * 2]);
            float Ls = 0.f; f32x4 acc = (f32x4){0.f, 0.f, 0.f, 0.f};
#pragma unroll
            for (int w = 0; w < 8; ++w) { Ls += ML[((w * 2 + i) * 16 + qfin) * 2 + 1] * __builtin_amdgcn_exp2f(ML[((w * 2 + i) * 16 + qfin) * 2] - M);
                acc += *(const LAS f32x4*)(slab + ((w * 2 + i) * 16 + qfin) * 132 + 4 * ln); }
            L[i] = Ls; s[i] = acc;
        }
        const f32x4 of = s[0] * (1.0f / L[0]) - s[1] * (lam / L[1]);
        float ss = (of[0] * of[0] + of[1] * of[1]) + (of[2] * of[2] + of[3] * of[3]);
#pragma unroll
        for (int o2 = 1; o2 < 32; o2 <<= 1) ss += shx(ss, o2, lane);
        const float rs = oscale / sqrtf(ss * (1.0f / 128.0f) + LN_EPS);
        bf16_t* ob = Ob + (size_t)(SEQ + 16 * b + qfin) * DM + h * 128;
#pragma unroll
        for (int e = 0; e < 4; ++e) { const int d = 64 * (ln >> 4) + 4 * (4 * (ln & 3) + e) + ((ln >> 2) & 3); ob[d] = f2bf(of[e] * rs * subg[d]); }
    }
    LDS_WAIT(); __builtin_amdgcn_s_barrier(); asm volatile("" ::: "memory");
}
}

constexpr int N_PHASES = 30;
__global__ void __launch_bounds__(NWAVES * 64, 2) yoco_fwd(Args args) {
    extern __shared__ __attribute__((aligned(16))) unsigned char lds_raw[];
    LAS unsigned char* lds = (LAS unsigned char*)lds_raw;
    volatile LAS unsigned* MISC = (volatile LAS unsigned*)(lds + MISC_OFF);
    const int tid0 = threadIdx.x; const int wave0 = __builtin_amdgcn_readfirstlane(tid0 >> 6);
    const int G = gridDim.x; const int bx0 = blockIdx.x; const int vcu0 = (G % 8 == 0) ? (bx0 % 8) * (G / 8) + bx0 / 8 : bx0;
    gu32* ctl = (gu32*)(args.ws + WS_CTL);
    if (tid0 < 64) MISC[tid0] = 0u;
    __syncthreads();
    XcdBarrier bar; bar.bar = (unsigned*)ctl + CW_BAR; bar.x = 0; bar.st = nullptr;
    if (MK_ONE_LAUNCH) bar = xcd_barrier_post((unsigned*)ctl + CW_BAR, MISC + 8);
    const int lo = args.ph_lo, hi = args.ph_hi;

#define x_prompt (ap->in[0])
#define x_sample (ap->in[1])
#define state_pool (ap->in[2])
#define state_conv (ap->in[3])
#define cache_k (ap->in[4])
#define cache_v (ap->in[5])
#define ln1_g (ap->in[6])
#define ln1_b (ap->in[7])
#define ln2_g (ap->in[8])
#define ln2_b (ap->in[9])
#define w_pool (ap->in[10])
#define pool_scale (ap->in[11])
#define w_up (ap->in[12])
#define conv_w (ap->in[13])
#define conv_b (ap->in[14])
#define w_down (ap->in[15])
#define w_kv (ap->in[16])
#define w_q (ap->in[17])
#define lam_in (ap->in[18])
#define subln_g (ap->in[19])
#define w_o (ap->in[20])
#define WUP ((bf16_t*)(ws + WS_WUP))
#define WDN ((bf16_t*)(ws + WS_WDN))
#define WKVQ ((bf16_t*)(ws + WS_WKVQ))
#define WQ3 ((bf16_t*)(ws + WS_WQ3))
#define WO ((bf16_t*)(ws + WS_WO))
#define WPOOL ((bf16_t*)(ws + WS_WPOOL))
#define X ((float*)(ws + WS_X))
#define Y ((float*)(ws + WS_Y))
#define XN ((bf16_t*)(ws + WS_XN))
#define DIN ((bf16_t*)(ws + WS_DIN))
#define Gb ((bf16_t*)(ws + WS_G))
#define HH ((float*)(ws + WS_HH))
#define HT ((float*)(ws + WS_HT))
#define KB ((bf16_t*)(ws + WS_KB))
#define VB ((bf16_t*)(ws + WS_VB))
#define QB ((bf16_t*)(ws + WS_QB))
#define OB ((bf16_t*)(ws + WS_OB))
#define SLAB ((float*)(ws + WS_SLAB))
    const int NGW = G * NWAVES;
    int ph = 0;
#define PH_BEGIN if (ph >= lo && ph < hi) { const __attribute__((address_space(4))) Args* ap = (const __attribute__((address_space(4))) Args*)__builtin_amdgcn_kernarg_segment_ptr(); asm volatile("" : "+s"(ap)); unsigned char* ws = ap->ws; float* out = ap->out; int bx = bx0, vcu = vcu0; asm volatile("" : "+s"(bx), "+s"(vcu)); int tid; asm volatile("v_mbcnt_lo_u32_b32 %0, -1, 0\n\tv_mbcnt_hi_u32_b32 %0, -1, %0" : "=v"(tid)); tid += wave0 * 64; const int lane = tid & 63; const int wave = __builtin_amdgcn_readfirstlane(tid >> 6); const int gw = vcu * NWAVES + wave; (void)lane; (void)gw;
#define PH_END if (MK_ONE_LAUNCH && ph + 1 < hi) xcd_barrier(bar, tid); } ++ph;

#define POOLDIFF(l, xp, xs) do { \
        for (int un = bx; un < 544; un += G) { \
            const bool smp = un >= 512; const int r0 = smp ? (un - 512) * 16 : un * 16; const int c0 = 4 * tid; \
            const float* xr = (smp ? (xs) : (xp)) + (size_t)r0 * DM + c0; \
            const float* hr = smp ? state_pool + ((size_t)((l) * 32 + (un - 512)) * 15) * DM + c0 : nullptr; \
            bf16_t* dr = DIN + (size_t)(smp ? SEQ + r0 : r0) * DM + c0; \
            const int grp = c0 >> 9; \
            if (grp == 0) pooldiff_rows2<2>(xr, hr, r0, smp, dr); else if (grp == 1) pooldiff_rows2<4>(xr, hr, r0, smp, dr); \
            else if (grp == 2) pooldiff_rows2<8>(xr, hr, r0, smp, dr); else pooldiff_rows2<16>(xr, hr, r0, smp, dr); \
            if (smp) { float* po = out + O_POOLS + ((size_t)((l) * 32 + (un - 512)) * 15) * DM + c0; \
                for (int t = 1; t < 16; ++t) *(f32x4*)(po + (size_t)(t - 1) * DM) = *(const f32x4*)(xr + (size_t)t * DM); } \
            else if (un == 511) { float* po = out + O_POOLP + (size_t)(l) * 15 * DM + c0; \
                for (int t = 1; t < 16; ++t) *(f32x4*)(po + (size_t)(t - 1) * DM) = *(const f32x4*)(xr + (size_t)t * DM); } \
        } } while (0)
#define LNPHASE(gp, bp, xo, wr_xn, ks) do { \
        for (int m = gw; m < MROWS; m += NGW) { \
            const f32x4* yr = (const f32x4*)(Y + (size_t)m * DM) + lane; f32x4 v[8]; float s = 0.f; \
            if ((ks) > 0 && m >= SEQ) { const f32x4* xr0 = (const f32x4*)(X + (size_t)m * DM) + lane; \
                _Pragma("unroll") for (int j = 0; j < 8; ++j) v[j] = xr0[64 * j] * ALPHA; \
                for (int kc = 0; kc < (ks); ++kc) { const f32x4* sr = (const f32x4*)(SLAB + ((size_t)kc * NSAMP + (m - SEQ)) * DM) + lane; \
                    _Pragma("unroll") for (int j = 0; j < 8; ++j) v[j] += sr[64 * j]; } } \
            else { _Pragma("unroll") for (int j = 0; j < 8; ++j) v[j] = yr[64 * j]; } \
            _Pragma("unroll") for (int j = 0; j < 8; ++j) { s += (v[j][0] + v[j][1]) + (v[j][2] + v[j][3]); } \
            const float mean = wave_sum(s, lane) * (1.f / DM); float s2 = 0.f; \
            _Pragma("unroll") for (int j = 0; j < 8; ++j) { v[j] = v[j] - mean; s2 += (v[j][0] * v[j][0] + v[j][1] * v[j][1]) + (v[j][2] * v[j][2] + v[j][3] * v[j][3]); } \
            const float rstd = 1.f / sqrtf(wave_sum(s2, lane) * (1.f / DM) + LN_EPS); \
            f32x4* xr = (f32x4*)((xo) + (size_t)m * DM) + lane; u32x2* nr = (u32x2*)(XN + (size_t)m * DM) + lane; \
            _Pragma("unroll") for (int j = 0; j < 8; ++j) { const f32x4 gg = ((const f32x4*)(gp))[lane + 64 * j], bb = ((const f32x4*)(bp))[lane + 64 * j]; \
                const f32x4 r = v[j] * rstd * gg + bb; xr[64 * j] = r; \
                if (wr_xn) { u32x2 o; o.x = cvt_pk_bf16(r[0], r[1]); o.y = cvt_pk_bf16(r[2], r[3]); nr[64 * j] = o; } } \
        } } while (0)

    PH_BEGIN
    if (KON(0)) KREP(0) {
        LAS float* scr = (LAS float*)(lds + wave * 16384);
        constexpr int I_UP = (DM / 64) * (NUP / 32), I_DN = (DFF / 64) * (DM / 32), I_KV = (DM / 64) * (4096 / 32), I_SQ = (DM / 64) * (DM / 32), I_PL = (512 / 64) * (512 / 32);
        constexpr int NITEMS = 4 * I_UP + 4 * I_DN + I_KV + 2 * I_SQ + 2 * I_SQ + 8 * I_PL;
        for (int it = gw; it < NITEMS; it += NGW) {
            int r = it;
            if (r < 4 * I_UP) { const int l = r / I_UP; transpose_item(w_up + (size_t)l * DM * NUP, DM, NUP, WUP + (size_t)l * NUP * DM, 0, 1, scr, r % I_UP, lane); continue; } r -= 4 * I_UP;
            if (r < 4 * I_DN) { const int l = r / I_DN; transpose_item(w_down + (size_t)l * DFF * DM, DFF, DM, WDN + (size_t)l * DM * DFF, 0, 0, scr, r % I_DN, lane); continue; } r -= 4 * I_DN;
            if (r < I_KV) { transpose_item(w_kv, DM, 4096, WKVQ, 0, 0, scr, r, lane); continue; } r -= I_KV;
            if (r < 2 * I_SQ) { const int j = r / I_SQ; transpose_item(w_q + (size_t)j * DM * DM, DM, DM, j == 0 ? WKVQ : WQ3, j == 0 ? 4096 : 0, 0, scr, r % I_SQ, lane); continue; } r -= 2 * I_SQ;
            if (r < 2 * I_SQ) { const int j = r / I_SQ; transpose_item(w_o + (size_t)j * DM * DM, DM, DM, WO + (size_t)j * DM * DM, 0, 0, scr, r % I_SQ, lane); continue; } r -= 2 * I_SQ;
            { const int lg = r / I_PL; transpose_item(w_pool + (size_t)lg * 512 * 512, 512, 512, WPOOL + (size_t)(lg / 4) * DM * 512, (lg % 4) * 512, 0, scr, r % I_PL, lane); }
        }
        if (KON(1)) KREP(1) POOLDIFF(0, x_prompt, x_sample);
    }
    PH_END

    for (int l = 0; l < DEPTH; ++l) {
        if (l < 2) {
            if (l == 1) {
                PH_BEGIN
                if (KON(1)) KREP(1) POOLDIFF(1, X, X + (size_t)SEQ * DM);
                PH_END
            }
            PH_BEGIN
            if (KON(2)) KREP(2) { pg8::Gemm g{DIN, WPOOL + (size_t)l * DM * 512, DM, 512, 512, 2}; pg8::StaticOrder S; S.init(8, 8, 1, G, bx);
              pg8::EpiRes E{l == 0 ? x_prompt : X, l == 0 ? x_sample : X + (size_t)SEQ * DM, Y, pool_scale + (size_t)l * DM, nullptr};
              pg8::gemm_phase<pg8::EpiRes, true>(lds, g, S, E, tid); }
            PH_END
        } else {
            const int j = l - 2;
            if (l == 2) {
                PH_BEGIN
                if (KON(3)) KREP(3) { pg8::Gemm g{XN, WKVQ, DM, DM, DM, 0}; pg8::StaticOrder S; S.init(24, 32, 1, G, bx);
                  pg8::EpiKVQ E{out + O_KP, out + O_KS, KB, 0};
                  pg8::gemm_phase<pg8::EpiKVQ, true>(lds, g, S, E, tid); }
                PH_END
            } else {
                PH_BEGIN
                if (KON(4)) KREP(4) { pg8::Gemm g{XN, WQ3, DM, DM, DM, 0}; pg8::StaticOrder S; S.init(8, 32, 1, G, bx);
                  pg8::EpiKVQ E{nullptr, nullptr, KB, 2};
                  pg8::gemm_phase<pg8::EpiKVQ, true>(lds, g, S, E, tid); }
                PH_END
            }
            PH_BEGIN
            if (KON(5)) KREP(5) {
                const float lam_init = (l == 2) ? 0.47071301834583585f : 0.5560582041547941f;
                const float* lp = lam_in + (size_t)j * 256;
                const float s01 = wave_sum(lp[lane] * lp[64 + lane], lane), s23 = wave_sum(lp[128 + lane] * lp[192 + lane], lane);
                const float lam = expf(s01) - expf(s23) + lam_init;
                const float oscale = 1.0f - lam_init;
                const float* sg = subln_g + (size_t)j * 128;
                KREP(12) for (int un = vcu; un < 256; un += G) {
                    const int h = un >> 4, s = un & 15;
#pragma unroll 1
                    for (int k2 = 0; k2 < 2; ++k2) att::prompt_unit(h, k2 ? 31 - s : s, QB, KB, VB, OB, lam, sg, oscale, lds, tid);
                }
                KREP(11) for (int un = vcu; un < 512; un += G) att::sample_unit(un >> 4, un & 15, QB, cache_k, cache_v, out + O_KS, out + O_VS, OB, lam, sg, oscale, lds, tid);
            }
            PH_END
            PH_BEGIN
            if (KON(6)) KREP(6) { pg8::Gemm g{OB, WO + (size_t)j * DM * DM, DM, DM, DM, 0}; pg8::StaticOrder S; S.init(8, 32, 4, G, bx);
              pg8::EpiRes E{X, X + (size_t)SEQ * DM, Y, nullptr, SLAB};
              pg8::gemm_phase<pg8::EpiRes, true>(lds, g, S, E, tid); }
            PH_END
        }
        PH_BEGIN
        if (KON(7)) KREP(7) LNPHASE(ln1_g + (size_t)l * DM, ln1_b + (size_t)l * DM, X, true, (l >= 2 ? 4 : 0));
        PH_END
        PH_BEGIN
        if (KON(8)) KREP(8) { pg8::Gemm g{XN, WUP + (size_t)l * NUP * DM, DM, DM, DM, 0}; pg8::StaticOrder S; S.init(44, 32, 1, G, bx);
          pg8::EpiUp E{conv_w + (size_t)l * 3 * NUP, conv_b + (size_t)l * NUP, state_conv + (size_t)l * 32 * 2 * NUP, Gb, HH, HT, out + O_CONVP + (size_t)l * 2 * NUP, out + O_CONVS + (size_t)l * 32 * 2 * NUP};
          pg8::gemm_phase<pg8::EpiUp, true>(lds, g, S, E, tid); }
        PH_END
        PH_BEGIN
        if (KON(9)) KREP(9) {
            const float* cw = conv_w + (size_t)l * 3 * NUP; const float* cbp = conv_b + (size_t)l * NUP;
            for (int it = bx * 512 + tid; it < 63 * 2 * (DFF / 4); it += G * 512) {
                const int f = (it % (DFF / 4)) * 4, rr = (it / (DFF / 4)) & 1, pm = 1 + it / (2 * (DFF / 4));
                float gg[4];
                f32x4 cc[2];
#pragma unroll
                for (int bj = 0; bj < 2; ++bj) { const int col = bj * DFF + f;
                    const f32x4 hd0 = *(const f32x4*)(HH + (size_t)(pm * 2 + 0) * NUP + col), hd1 = *(const f32x4*)(HH + (size_t)(pm * 2 + 1) * NUP + col);
                    const f32x4 tl0 = *(const f32x4*)(HT + (size_t)((pm - 1) * 2 + 0) * NUP + col), tl1 = *(const f32x4*)(HT + (size_t)((pm - 1) * 2 + 1) * NUP + col);
                    const f32x4 h0 = rr ? hd1 : hd0, hm1 = rr ? hd0 : tl1, hm2 = rr ? tl1 : tl0;
                    cc[bj] = *(const f32x4*)(cbp + col) + *(const f32x4*)(cw + 2 * NUP + col) * h0 + *(const f32x4*)(cw + NUP + col) * hm1 + *(const f32x4*)(cw + col) * hm2; }
#pragma unroll
                for (int jj = 0; jj < 4; ++jj) gg[jj] = pg8::gelu_tanh(cc[0][jj]) * cc[1][jj];
                u32x2 o; o.x = cvt_pk_bf16(gg[0], gg[1]); o.y = cvt_pk_bf16(gg[2], gg[3]);
                *(u32x2*)(Gb + (size_t)(pm * 128 + rr) * DFF + f) = o;
            }
        }
        PH_END
        PH_BEGIN
        if (KON(10)) KREP(10) { pg8::Gemm g{Gb, WDN + (size_t)l * DM * DFF, DFF, DFF, DFF, 0}; pg8::StaticOrder S; S.init(8, 88, 11, G, bx);
          pg8::EpiRes E{X, X + (size_t)SEQ * DM, Y, nullptr, SLAB};
          pg8::gemm_phase<pg8::EpiRes, true>(lds, g, S, E, tid); }
        PH_END
        PH_BEGIN
        if (!KON(7)) {} else if (l == DEPTH - 1) { LNPHASE(ln2_g + (size_t)l * DM, ln2_b + (size_t)l * DM, out + O_Y, false, 11); }
        else { LNPHASE(ln2_g + (size_t)l * DM, ln2_b + (size_t)l * DM, X, true, 11); }
        PH_END
    }
#undef PH_BEGIN
#undef PH_END
}

extern "C" void kernel_launch(void* const* d_in, const int* in_sizes, int n_in, void* d_out, int out_size, void* d_ws, size_t ws_size, hipStream_t stream) {
    static int grid = 0;
    if (grid == 0) {
        if (n_in != 21 || ws_size < WS_END) { fprintf(stderr, "kernel_launch: unexpected inputs (n_in %d, ws %zu, need %zu)\n", n_in, ws_size, (size_t)WS_END); grid = -1; return; }
        int dev = 0, cus = 0, per_cu = 0;
        if (hipGetDevice(&dev) != hipSuccess || hipDeviceGetAttribute(&cus, hipDeviceAttributeMultiprocessorCount, dev) != hipSuccess) { grid = -1; return; }
        if (hipFuncSetAttribute((const void*)yoco_fwd, hipFuncAttributeMaxDynamicSharedMemorySize, LDS_BYTES) != hipSuccess) { fprintf(stderr, "kernel_launch: hipFuncSetAttribute failed\n"); grid = -1; return; }
        if (hipOccupancyMaxActiveBlocksPerMultiprocessor(&per_cu, (const void*)yoco_fwd, NWAVES * 64, LDS_BYTES) != hipSuccess || per_cu < 1)
            fprintf(stderr, "kernel_launch: occupancy query reports %d workgroups per CU\n", per_cu);
        (void)hipGetLastError();
        grid = cus;
    }
    if (grid < 0) return;
    (void)hipMemsetAsync((char*)d_ws + WS_CTL, 0, CTL_ZERO_BYTES, stream);
    Args a{};
    for (int i = 0; i < 21; ++i) a.in[i] = (const float*)d_in[i];
    a.out = (float*)d_out; a.ws = (unsigned char*)d_ws;
#if MK_ONE_LAUNCH
    a.ph_lo = 0; a.ph_hi = N_PHASES;
    hipLaunchKernelGGL(yoco_fwd, dim3(grid), dim3(NWAVES * 64), LDS_BYTES, stream, a);
#else
    for (int p = 0; p < N_PHASES; ++p) { a.ph_lo = p; a.ph_hi = p + 1; hipLaunchKernelGGL(yoco_fwd, dim3(grid), dim3(NWAVES * 64), LDS_BYTES, stream, a); }
#endif
}
```
